# Optimizing an MI355X kernel written in HIP

```python
import jax
import jax.numpy as jnp
from jax import lax
import numpy as np


D_MODEL = 2048
BATCH = 2
SEQ = 4096
DEPTH = 4

N_META = 16
BLOCK = 128
PAD = BLOCK - N_META
EPS = 1e-6
NEG_INF = -1e30
ROPE_BASE = 10000.0
HALF_STEP = 0.5

SWA_HEADS = 16
SWA_KV_HEADS = 2
SWA_HEAD_DIM = 64
SWA_GROUP = SWA_HEADS // SWA_KV_HEADS
WINDOW = 128

MLA_HEADS = 8
MLA_Q_RANK = 512
MLA_KV_RANK = 512
MLA_NOPE_DIM = 128
MLA_ROPE_DIM = 64
MLA_V_DIM = 128

RET_HEADS = 4
RET_KEY_DIM = 128
RET_VAL_DIM = 256

D_FF = 5632
N_BRANCH = 3

SWA_OUT = SWA_HEADS * SWA_HEAD_DIM
SWA_KV_W = SWA_KV_HEADS * SWA_HEAD_DIM
MLA_OUT = MLA_HEADS * MLA_V_DIM
RET_QK_W = RET_HEADS * RET_KEY_DIM
RET_OUT = RET_HEADS * RET_VAL_DIM
IN_WIDTHS = (SWA_OUT, SWA_KV_W, SWA_KV_W, MLA_Q_RANK, MLA_KV_RANK, MLA_ROPE_DIM,
             RET_QK_W, RET_QK_W, RET_OUT, RET_OUT, N_BRANCH * D_MODEL)
IN_WIDTH = sum(IN_WIDTHS)

kernel_name = 'hybrid_swa_mla_retention_macaron'


def _rms_norm(x, g):
    xf = x.astype(jnp.float32)
    y = xf * lax.rsqrt(jnp.mean(xf * xf, axis=-1, keepdims=True) + EPS)
    return (y * g.astype(jnp.float32)).astype(x.dtype)


def _rope(x, pos):
    half = x.shape[-1] // 2
    inv_freq = ROPE_BASE ** (-jnp.arange(half, dtype=jnp.float32) / half)
    ang = pos[:, None] * inv_freq[None, :]
    cos = jnp.cos(ang)[None, :, None, :]
    sin = jnp.sin(ang)[None, :, None, :]
    xf = x.astype(jnp.float32)
    x1, x2 = xf[..., :half], xf[..., half:]
    return jnp.concatenate([x1 * cos - x2 * sin, x2 * cos + x1 * sin], axis=-1).astype(x.dtype)


def _swiglu(x, w_gate, w_up, w_down):
    return (jax.nn.silu(x @ w_gate) * (x @ w_up)) @ w_down


def _sliding_window_attention(q, k, v, sinks):
    B, L = q.shape[0], q.shape[1]
    nb = L // BLOCK
    qb = q.reshape(B, nb, BLOCK, SWA_KV_HEADS, SWA_GROUP, SWA_HEAD_DIM)
    kb = k.reshape(B, nb, BLOCK, SWA_KV_HEADS, SWA_HEAD_DIM)
    vb = v.reshape(B, nb, BLOCK, SWA_KV_HEADS, SWA_HEAD_DIM)
    shift = ((0, 0), (1, 0), (0, 0), (0, 0), (0, 0))
    k_prev = jnp.pad(kb[:, :-1], shift)
    v_prev = jnp.pad(vb[:, :-1], shift)
    meta_shape = (B, nb, N_META, SWA_KV_HEADS, SWA_HEAD_DIM)
    k_meta = jnp.broadcast_to(k[:, None, PAD:BLOCK], meta_shape)
    v_meta = jnp.broadcast_to(v[:, None, PAD:BLOCK], meta_shape)
    keys = jnp.concatenate([k_meta, k_prev, kb], axis=2)
    vals = jnp.concatenate([v_meta, v_prev, vb], axis=2)
    s = jnp.einsum('bnqhgd,bnkhd->bnhgqk', qb, keys).astype(jnp.float32) * (SWA_HEAD_DIM ** -0.5)
    q_pos = jnp.arange(nb * BLOCK).reshape(nb, BLOCK)
    k_pos = jnp.arange(nb)[:, None] * BLOCK - BLOCK + jnp.arange(2 * BLOCK)[None, :]
    meta_pos = PAD + jnp.arange(N_META)
    diff_w = q_pos[:, :, None] - k_pos[:, None, :]
    win_ok = (diff_w >= 0) & (diff_w < WINDOW) & (k_pos[:, None, :] >= PAD)
    meta_ok = (q_pos[:, :, None] - meta_pos[None, None, :]) >= WINDOW
    mask = jnp.concatenate([meta_ok, win_ok], axis=-1)
    s = jnp.where(mask[None, :, None, None], s, NEG_INF)
    sink = jnp.broadcast_to(sinks.astype(jnp.float32).reshape(1, 1, SWA_KV_HEADS, SWA_GROUP, 1, 1),
                            s.shape[:-1] + (1,))
    p = jax.nn.softmax(jnp.concatenate([s, sink], axis=-1), axis=-1)[..., :-1]
    o = jnp.einsum('bnhgqk,bnkhd->bnqhgd', p.astype(v.dtype), vals)
    return o.reshape(B, L, SWA_OUT)


def _mla(c_q, c_kv, k_rope, q_a_norm, w_uq, kv_a_norm, w_ukv, qn_norm, qr_norm, kn_norm, kr_norm, pos):
    B, L = c_q.shape[0], c_q.shape[1]
    nb = L // BLOCK
    q = (_rms_norm(c_q, q_a_norm) @ w_uq).reshape(B, L, MLA_HEADS, MLA_NOPE_DIM + MLA_ROPE_DIM)
    kv = (_rms_norm(c_kv, kv_a_norm) @ w_ukv).reshape(B, L, MLA_HEADS, MLA_NOPE_DIM + MLA_V_DIM)
    q_nope = _rms_norm(q[..., :MLA_NOPE_DIM], qn_norm)
    q_rope = _rope(_rms_norm(q[..., MLA_NOPE_DIM:], qr_norm), pos)
    k_nope = _rms_norm(kv[..., :MLA_NOPE_DIM], kn_norm)
    v = kv[..., MLA_NOPE_DIM:]
    k_r = _rope(_rms_norm(k_rope, kr_norm)[:, :, None, :], pos)[:, :, 0, :]
    scale = (MLA_NOPE_DIM + MLA_ROPE_DIM) ** -0.5
    k_idx = jnp.arange(L)
    qn_b = q_nope.reshape(B, nb, BLOCK, MLA_HEADS, MLA_NOPE_DIM).transpose(1, 0, 2, 3, 4)
    qr_b = q_rope.reshape(B, nb, BLOCK, MLA_HEADS, MLA_ROPE_DIM).transpose(1, 0, 2, 3, 4)
    qi_b = k_idx.reshape(nb, BLOCK)

    def q_block(args):
        qn, qr, qi = args
        s = (jnp.einsum('bqhd,bkhd->bhqk', qn, k_nope)
             + jnp.einsum('bqhd,bkd->bhqk', qr, k_r)).astype(jnp.float32) * scale
        ok = (k_idx[None, :] <= qi[:, None]) & (k_idx[None, :] >= PAD)
        p = jax.nn.softmax(jnp.where(ok[None, None], s, NEG_INF), axis=-1)
        return jnp.einsum('bhqk,bkhd->bqhd', p.astype(v.dtype), v)

    o = lax.map(q_block, (qn_b, qr_b, qi_b))
    return o.transpose(1, 0, 2, 3, 4).reshape(B, L, MLA_OUT)


def _retention(q, k, v):
    B, L, H, dk = q.shape
    dv = v.shape[-1]
    nc = L // BLOCK
    log_gamma = jnp.log(1.0 - 2.0 ** (-5.0 - jnp.arange(H, dtype=jnp.float32)))
    idx = jnp.arange(BLOCK, dtype=jnp.float32)
    qc = q.reshape(B, nc, BLOCK, H, dk)
    kc = k.reshape(B, nc, BLOCK, H, dk)
    vc = v.reshape(B, nc, BLOCK, H, dv)
    diff = idx[:, None] - idx[None, :]
    decay = jnp.where(diff[None] >= 0,
                      jnp.exp(jnp.maximum(diff, 0.0)[None] * log_gamma[:, None, None]), 0.0)
    s = jnp.einsum('bnqhd,bnkhd->bnhqk', qc, kc) * decay
    inner = jnp.einsum('bnhqk,bnkhe->bnqhe', s, vc)
    zeta = jnp.exp((BLOCK - 1.0 - idx)[None, :] * log_gamma[:, None])
    kv_chunk = jnp.einsum('bnkhd,hk,bnkhe->nbhde', kc, zeta, vc)
    chunk_decay = jnp.exp(BLOCK * log_gamma)[None, :, None, None]

    def step(state, kv):
        return state * chunk_decay + kv, state

    _, prev = lax.scan(step, jnp.zeros((B, H, dk, dv), jnp.float32), kv_chunk)
    xi = jnp.exp((idx + 1.0)[None, :] * log_gamma[:, None])
    cross = jnp.einsum('bnqhd,nbhde,hq->bnqhe', qc, prev, xi)
    return (inner + cross).reshape(B, L, H, dv)


def _group_norm(o, g):
    B, L = o.shape[0], o.shape[1]
    mu = jnp.mean(o, axis=-1, keepdims=True)
    var = jnp.mean(jnp.square(o - mu), axis=-1, keepdims=True)
    y = ((o - mu) * lax.rsqrt(var + EPS)).reshape(B, L, -1)
    return y * g.astype(jnp.float32)


def _hybrid_mixer(hn, pos, w_in, swa_q_norm, swa_k_norm, swa_sinks,
                  mla_q_a_norm, mla_w_uq, mla_kv_a_norm, mla_w_ukv,
                  mla_qn_norm, mla_qr_norm, mla_kn_norm, mla_kr_norm,
                  ret_gn, w_br_swa, w_br_mla, w_br_ret, w_o):
    B, L, _ = hn.shape
    z = hn @ w_in
    splits = np.cumsum(np.array(IN_WIDTHS))[:-1].tolist()
    (swa_q, swa_k, swa_v, mla_cq, mla_ckv, mla_kr,
     ret_q, ret_k, ret_v, ret_g, gate_pre) = jnp.split(z, splits, axis=-1)

    qa = _rms_norm(swa_q.reshape(B, L, SWA_HEADS, SWA_HEAD_DIM), swa_q_norm)
    ka = _rms_norm(swa_k.reshape(B, L, SWA_KV_HEADS, SWA_HEAD_DIM), swa_k_norm)
    va = swa_v.reshape(B, L, SWA_KV_HEADS, SWA_HEAD_DIM)
    o_a = _sliding_window_attention(qa, ka, va, swa_sinks)

    o_b = _mla(mla_cq, mla_ckv, mla_kr, mla_q_a_norm, mla_w_uq, mla_kv_a_norm, mla_w_ukv,
               mla_qn_norm, mla_qr_norm, mla_kn_norm, mla_kr_norm, pos)

    valid = (jnp.arange(L) >= PAD).astype(jnp.float32)[None, :, None, None]
    qc = _rope(ret_q.reshape(B, L, RET_HEADS, RET_KEY_DIM), pos).astype(jnp.float32)
    kc = _rope(ret_k.reshape(B, L, RET_HEADS, RET_KEY_DIM), pos).astype(jnp.float32) * (RET_KEY_DIM ** -0.5) * valid
    vc = ret_v.reshape(B, L, RET_HEADS, RET_VAL_DIM).astype(jnp.float32)
    o_c = (_group_norm(_retention(qc, kc, vc), ret_gn) * jax.nn.silu(ret_g.astype(jnp.float32))).astype(hn.dtype)

    g = jax.nn.sigmoid(gate_pre.astype(jnp.float32)).astype(hn.dtype).reshape(B, L, N_BRANCH, D_MODEL)
    merged = (g[:, :, 0] * (o_a @ w_br_swa) + g[:, :, 1] * (o_b @ w_br_mla)
              + g[:, :, 2] * (o_c @ w_br_ret))
    return merged @ w_o


def setup_inputs(seed: int = 0) -> dict:
    key = jax.random.key(seed)
    k = jax.random.split(key, 32)
    f32 = jnp.float32

    def w(i, shape, fan_in):
        return jax.random.normal(k[i], shape, f32) * (fan_in ** -0.5)

    def gain(i, shape):
        return 1.0 + 0.02 * jax.random.normal(k[i], shape, f32)

    return {
        'x': jax.random.normal(k[0], (BATCH, SEQ, D_MODEL), f32),
        'meta_tokens': jax.random.normal(k[1], (N_META, D_MODEL), f32),
        'ffn1_norm': gain(2, (DEPTH, D_MODEL)),
        'ffn1_w_gate': w(3, (DEPTH, D_MODEL, D_FF), D_MODEL),
        'ffn1_w_up': w(4, (DEPTH, D_MODEL, D_FF), D_MODEL),
        'ffn1_w_down': w(5, (DEPTH, D_FF, D_MODEL), D_FF),
        'mix_norm': gain(6, (DEPTH, D_MODEL)),
        'w_in': w(7, (DEPTH, D_MODEL, IN_WIDTH), D_MODEL),
        'swa_q_norm': gain(8, (DEPTH, SWA_HEAD_DIM)),
        'swa_k_norm': gain(9, (DEPTH, SWA_HEAD_DIM)),
        'swa_sinks': 0.5 * jax.random.normal(k[10], (DEPTH, SWA_HEADS), f32),
        'mla_q_a_norm': gain(11, (DEPTH, MLA_Q_RANK)),
        'mla_w_uq': w(12, (DEPTH, MLA_Q_RANK, MLA_HEADS * (MLA_NOPE_DIM + MLA_ROPE_DIM)), MLA_Q_RANK),
        'mla_kv_a_norm': gain(13, (DEPTH, MLA_KV_RANK)),
        'mla_w_ukv': w(14, (DEPTH, MLA_KV_RANK, MLA_HEADS * (MLA_NOPE_DIM + MLA_V_DIM)), MLA_KV_RANK),
        'mla_qn_norm': gain(15, (DEPTH, MLA_NOPE_DIM)),
        'mla_qr_norm': gain(16, (DEPTH, MLA_ROPE_DIM)),
        'mla_kn_norm': gain(17, (DEPTH, MLA_NOPE_DIM)),
        'mla_kr_norm': gain(18, (DEPTH, MLA_ROPE_DIM)),
        'ret_gn': gain(19, (DEPTH, RET_OUT)),
        'w_br_swa': w(20, (DEPTH, SWA_OUT, D_MODEL), SWA_OUT),
        'w_br_mla': w(21, (DEPTH, MLA_OUT, D_MODEL), MLA_OUT),
        'w_br_ret': w(22, (DEPTH, RET_OUT, D_MODEL), RET_OUT),
        'w_o': w(23, (DEPTH, D_MODEL, D_MODEL), D_MODEL),
        'ffn2_norm': gain(24, (DEPTH, D_MODEL)),
        'ffn2_w_gate': w(25, (DEPTH, D_MODEL, D_FF), D_MODEL),
        'ffn2_w_up': w(26, (DEPTH, D_MODEL, D_FF), D_MODEL),
        'ffn2_w_down': w(27, (DEPTH, D_FF, D_MODEL), D_FF),
    }


def reference(x, meta_tokens, ffn1_norm, ffn1_w_gate, ffn1_w_up, ffn1_w_down, mix_norm, w_in,
              swa_q_norm, swa_k_norm, swa_sinks, mla_q_a_norm, mla_w_uq, mla_kv_a_norm, mla_w_ukv,
              mla_qn_norm, mla_qr_norm, mla_kn_norm, mla_kr_norm, ret_gn, w_br_swa, w_br_mla,
              w_br_ret, w_o, ffn2_norm, ffn2_w_gate, ffn2_w_up, ffn2_w_down):
    B = x.shape[0]
    meta = jnp.broadcast_to(meta_tokens[None].astype(x.dtype), (B, N_META, D_MODEL))
    pad = jnp.zeros((B, PAD, D_MODEL), x.dtype)
    h = jnp.concatenate([pad, meta, x], axis=1)
    L = h.shape[1]
    pos = (jnp.arange(L) - PAD).astype(jnp.float32)
    for l in range(DEPTH):
        h = h + HALF_STEP * _swiglu(_rms_norm(h, ffn1_norm[l]), ffn1_w_gate[l], ffn1_w_up[l], ffn1_w_down[l])
        h = h + _hybrid_mixer(_rms_norm(h, mix_norm[l]), pos, w_in[l], swa_q_norm[l], swa_k_norm[l],
                              swa_sinks[l], mla_q_a_norm[l], mla_w_uq[l], mla_kv_a_norm[l], mla_w_ukv[l],
                              mla_qn_norm[l], mla_qr_norm[l], mla_kn_norm[l], mla_kr_norm[l], ret_gn[l],
                              w_br_swa[l], w_br_mla[l], w_br_ret[l], w_o[l])
        h = h + HALF_STEP * _swiglu(_rms_norm(h, ffn2_norm[l]), ffn2_w_gate[l], ffn2_w_up[l], ffn2_w_down[l])
    return h[:, BLOCK:]
```

```cpp
#include <hip/hip_runtime.h>
#include <cstdio>
#include <cstdint>
#include <cmath>
namespace pg8 {
#define PG8_LAS __attribute__((address_space(3)))
typedef unsigned short bf16_t;
typedef short bf16x8 __attribute__((ext_vector_type(8)));
typedef float f32x4 __attribute__((ext_vector_type(4)));
typedef unsigned u32x4 __attribute__((ext_vector_type(4)));
constexpr int BM = 256, BK = 64, HALF = 128, HTB = HALF * BK * 2  , STAGE_BYTES = 8 * HTB, NXCD = 8, WGM = 8;

__host__ __device__ __forceinline__ int lds_byte(int r, int c) { const int st = (r >> 4) * 2 + (c >> 5), rr = r & 15, cc = c & 31, ob = rr * 64 + cc * 2; return st * 1024 + (ob ^ (((ob >> 9) & 1) << 5)); }
__host__ __device__ __forceinline__ void stage_rc(int b, int& R, int& C) { const int st = b / 1024, sb = b % 1024, swz = sb ^ (((sb >> 9) & 1) << 5); R = (st >> 1) * 16 + swz / 64; C = (st & 1) * 32 + (swz % 64) / 2; }
__host__ __device__ __forceinline__ int perm32(int rho) { const int n = rho >> 4, i = rho & 15; return 8 * (i >> 2) + 4 * n + (i & 3); }

struct Unit { int pm, pn, nk, tag; const char* a; const char* b; };
struct Gemm { const bf16_t* A; const bf16_t* Bt; int M, N, K, lda; };

struct StaticOrder {
    int nM, nN, nwg, G, c, K, lda; const char* A; const char* Bt;
    __host__ __device__ void init(const Gemm& g, int G_, int c_) { nM = g.M / BM; nN = g.N / BM; nwg = nM * nN; G = G_; c = c_; K = g.K; lda = g.lda; A = (const char*)g.A; Bt = (const char*)g.Bt; }
    __host__ __device__ bool next(int i, Unit& u) const {
        const long L = (long)i * G + c; if (L >= nwg) return false;
        int wgid = (int)L; { const int q = nwg / NXCD, r = nwg % NXCD, xcd = wgid % NXCD, off = wgid / NXCD; wgid = (xcd < r ? xcd * (q + 1) : r * (q + 1) + (xcd - r) * q) + off; }
        const int nig = WGM * nN, gid = wgid / nig, fm = gid * WGM, gsz = (nM - fm) < WGM ? (nM - fm) : WGM;
        u.pm = fm + ((wgid % nig) % gsz); u.pn = (wgid % nig) / gsz; u.nk = K / BK; u.tag = 0; u.a = A + (size_t)u.pm * ((size_t)BM * lda * 2); u.b = Bt + (size_t)u.pn * ((size_t)BM * K * 2); return true;
    }
    __device__ __forceinline__ void a_ready(const Unit&) const {}
    __device__ __forceinline__ void done(const Unit&) const {}
};

__device__ __forceinline__ unsigned cvt_pk_bf16(float lo, float hi) { unsigned r; asm volatile("v_cvt_pk_bf16_f32 %0, %1, %2" : "=v"(r) : "v"(lo), "v"(hi)); return r; }
typedef float f32x2 __attribute__((ext_vector_type(2)));
__device__ __forceinline__ f32x2 gelu_pk(f32x2 v) {
    const f32x2 av = __builtin_elementwise_abs(v), d = av * 0.2316418882f + 1.0f;
    f32x2 t; t.x = __builtin_amdgcn_rcpf(d.x); t.y = __builtin_amdgcn_rcpf(d.y);
    f32x2 q = t * 0.5307027145f + (-0.7265760135f); q = q * t + 0.7107068705f; q = q * t + (-0.142248368f); q = q * t + 0.127414796f; q = q * t;
    const f32x2 s = (v * v) * (-0.72134752044f);
    f32x2 e; e.x = __builtin_amdgcn_exp2f(s.x); e.y = __builtin_amdgcn_exp2f(s.y);
    const f32x2 m = v * (q * e), r = v - m;
    f32x2 o; o.x = v.x < 0.f ? m.x : r.x; o.y = v.y < 0.f ? m.y : r.y; return o;
}

template <int ACT  > struct EpiBf16 {
    static constexpr bool PERM = true, AFTER_DRAIN = false; static_assert(ACT == 0 || ACT == 1, "EpiBf16: ACT is 0 (none) or 1 (gelu_pk)");
    bf16_t* O; int ldc; const float* bias; int split_cols; size_t split_stride; float scale0;
    __device__ __forceinline__ void operator()(const f32x4 (&acc)[2][2][4][2], const Unit& u, int wr, int wc, int fr, int fq) const {
        const int row0 = u.pm * BM + wr * 64 + fr; int colt = u.pn * BM; bf16_t* base = O;
        float sc = 1.f; if (split_cols) { const int t = colt / split_cols; base += (size_t)t * split_stride; colt -= t * split_cols; if (t == 0) sc = scale0; }
        const int col0 = colt + wc * 32 + 8 * fq, bcol0 = u.pn * BM + wc * 32 + 8 * fq;
        f32x4 bv[2][2];
#pragma unroll
        for (int bj = 0; bj < 2; ++bj)
#pragma unroll
            for (int n = 0; n < 2; ++n) bv[bj][n] = bias ? *(const f32x4*)(bias + bcol0 + bj * HALF + 4 * n) : (f32x4){0.f, 0.f, 0.f, 0.f};
#pragma unroll
        for (int ai = 0; ai < 2; ++ai)
#pragma unroll
            for (int m = 0; m < 4; ++m) { bf16_t* rowp = base + (size_t)(row0 + ai * HALF + m * 16) * ldc + col0;
#pragma unroll
                for (int bj = 0; bj < 2; ++bj) { f32x4 v0 = acc[ai][bj][m][0] + bv[bj][0], v1 = acc[ai][bj][m][1] + bv[bj][1];
                    if (ACT == 1) { f32x2 a = gelu_pk((f32x2){v0[0], v0[1]}), b = gelu_pk((f32x2){v0[2], v0[3]}), c = gelu_pk((f32x2){v1[0], v1[1]}), d = gelu_pk((f32x2){v1[2], v1[3]});
                        v0 = (f32x4){a.x, a.y, b.x, b.y}; v1 = (f32x4){c.x, c.y, d.x, d.y}; }
                    v0 = v0 * sc; v1 = v1 * sc; u32x4 w; w.x = cvt_pk_bf16(v0[0], v0[1]); w.y = cvt_pk_bf16(v0[2], v0[3]); w.z = cvt_pk_bf16(v1[0], v1[1]); w.w = cvt_pk_bf16(v1[2], v1[3]);
                    *(u32x4*)(rowp + bj * HALF) = w; } }
    }
};
__device__ __forceinline__ float silu_f(float x) { return x * __builtin_amdgcn_rcpf(1.0f + __expf(-x)); }
__device__ __forceinline__ float sigmoid_f(float x) { return __builtin_amdgcn_rcpf(1.0f + __expf(-x)); }
__device__ __forceinline__ float bf_lo(unsigned w) { return __uint_as_float(w << 16); }
__device__ __forceinline__ float bf_hi(unsigned w) { return __uint_as_float(w & 0xffff0000u); }
__device__ __forceinline__ float row_scale(const float* SSQ, int row) {
    const f32x4* q = (const f32x4*)(SSQ + (size_t)row * 32); f32x4 a = q[0];
#pragma unroll
    for (int i = 1; i < 8; ++i) a = a + q[i];
    return __builtin_amdgcn_rsqf(((a[0] + a[1]) + (a[2] + a[3])) * (1.0f / 2048.0f) + 1e-6f);
}
struct EpiSwiglu {
    static constexpr bool PERM = true, AFTER_DRAIN = false;
    bf16_t* O; int ldc; const float* SSQ;
    static constexpr bool ROWSC = true;
    __device__ __forceinline__ void operator()(const f32x4 (&acc)[2][2][4][2], const Unit& u, int wr, int wc, int fr, int fq, const PG8_LAS float* rsl) const {
        asm volatile("" : "+v"(fr), "+v"(fq));
        const int row0 = u.pm * BM + wr * 64 + fr, col0 = u.pn * HALF + wc * 32 + 8 * fq;
        float rr[2][4];
#pragma unroll
        for (int ai = 0; ai < 2; ++ai)
#pragma unroll
            for (int m = 0; m < 4; ++m) rr[ai][m] = rsl[wr * 64 + fr + ai * HALF + m * 16];
        asm volatile("" : "+v"(rr[0][0]), "+v"(rr[0][1]), "+v"(rr[0][2]), "+v"(rr[0][3]), "+v"(rr[1][0]), "+v"(rr[1][1]), "+v"(rr[1][2]), "+v"(rr[1][3]));
#pragma unroll
        for (int ai = 0; ai < 2; ++ai)
#pragma unroll
            for (int m = 0; m < 4; ++m) { const int row = row0 + ai * HALF + m * 16; bf16_t* p = O + (size_t)row * ldc + col0;
                const float r = rr[ai][m], rl = r * -1.44269504088896f, r2 = r * r;
                u32x4 w;
#pragma unroll
                for (int n = 0; n < 2; ++n)
#pragma unroll
                    for (int hf = 0; hf < 2; ++hf) { const f32x2 g = {acc[ai][0][m][n][2 * hf], acc[ai][0][m][n][2 * hf + 1]}, uu = {acc[ai][1][m][n][2 * hf], acc[ai][1][m][n][2 * hf + 1]};
                        const f32x2 a = g * rl; f32x2 e; e.x = __builtin_amdgcn_exp2f(a.x); e.y = __builtin_amdgcn_exp2f(a.y);
                        const f32x2 d = e + 1.0f; f32x2 sg; sg.x = __builtin_amdgcn_rcpf(d.x); sg.y = __builtin_amdgcn_rcpf(d.y);
                        const f32x2 o = (g * uu) * (sg * r2); w[2 * n + hf] = cvt_pk_bf16(o.x, o.y); }
                *(u32x4*)p = w; }
    }
};
struct EpiZ {
    static constexpr bool PERM = true, AFTER_DRAIN = false;
    bf16_t* O; int ldc; const float* SSQ; float* SSQC;
    static constexpr bool ROWSC = true;
    __device__ __forceinline__ void operator()(const f32x4 (&acc)[2][2][4][2], const Unit& u, int wr, int wc, int fr, int fq, const PG8_LAS float* rsl) const {
        asm volatile("" : "+v"(fr), "+v"(fq));
        const int row0 = u.pm * BM + wr * 64 + fr, col0 = u.pn * BM + wc * 32 + 8 * fq;
        float rr[2][4];
#pragma unroll
        for (int ai = 0; ai < 2; ++ai)
#pragma unroll
            for (int m = 0; m < 4; ++m) rr[ai][m] = rsl[wr * 64 + fr + ai * HALF + m * 16];
        asm volatile("" : "+v"(rr[0][0]), "+v"(rr[0][1]), "+v"(rr[0][2]), "+v"(rr[0][3]), "+v"(rr[1][0]), "+v"(rr[1][1]), "+v"(rr[1][2]), "+v"(rr[1][3]));
        const bool lowrank = u.pn >= 5 && u.pn <= 8;
#pragma unroll
        for (int ai = 0; ai < 2; ++ai)
#pragma unroll
            for (int m = 0; m < 4; ++m) { const int row = row0 + ai * HALF + m * 16; bf16_t* p = O + (size_t)row * ldc + col0;
                const float r = rr[ai][m]; float ss = 0.f;
#pragma unroll
                for (int bj = 0; bj < 2; ++bj) { const f32x4 v0 = acc[ai][bj][m][0] * r, v1 = acc[ai][bj][m][1] * r;
                    ss += ((v0[0] * v0[0] + v0[1] * v0[1]) + (v0[2] * v0[2] + v0[3] * v0[3])) + ((v1[0] * v1[0] + v1[1] * v1[1]) + (v1[2] * v1[2] + v1[3] * v1[3]));
                    u32x4 w; w.x = cvt_pk_bf16(v0[0], v0[1]); w.y = cvt_pk_bf16(v0[2], v0[3]); w.z = cvt_pk_bf16(v1[0], v1[1]); w.w = cvt_pk_bf16(v1[2], v1[3]);
                    *(u32x4*)(p + bj * HALF) = w; }
                if (lowrank) {
                    { float p0 = ss, p1 = ss; asm("s_nop 1\n\tv_permlane16_swap_b32 %0, %1" : "+v"(p0), "+v"(p1)); ss = p0 + p1; p0 = ss; p1 = ss; asm("s_nop 1\n\tv_permlane32_swap_b32 %0, %1" : "+v"(p0), "+v"(p1)); ss = p0 + p1; }
                    if (fq == 0) SSQC[(size_t)row * 16 + 4 * (u.pn - 5) + wc] = ss; } }
    }
};
struct DualOrder : StaticOrder {
    const char* A2; const char* B1; const char* B2;
    __device__ __forceinline__ bool next(int i, Unit& u) const {
        if (!StaticOrder::next(i, u)) return false;
        const size_t ta = (size_t)BM * lda * 2, tb = (size_t)BM * K * 2;
        if (u.pn < 6) { u.a = A + (size_t)u.pm * ta; u.b = B1 + (size_t)u.pn * tb; } else { u.a = A2 + (size_t)u.pm * ta; u.b = B2 + (size_t)(u.pn - 6) * tb; }
        return true;
    }
};
struct EpiQKV {
    static constexpr bool PERM = true, AFTER_DRAIN = false;
    bf16_t* OQ; bf16_t* OKV; const float* SSQC;
    __device__ __forceinline__ void operator()(const f32x4 (&acc)[2][2][4][2], const Unit& u, int wr, int wc, int fr, int fq) const {
        asm volatile("" : "+v"(fr), "+v"(fq));
        const bool isq = u.pn < 6; const int row0 = u.pm * BM + wr * 64 + fr, ldc = isq ? 1536 : 2048, col0 = (isq ? u.pn : u.pn - 6) * BM + wc * 32 + 8 * fq;
        bf16_t* base = isq ? OQ : OKV; const float* sq = SSQC + (isq ? 0 : 8);
        float rr[2][4];
#pragma unroll
        for (int ai = 0; ai < 2; ++ai)
#pragma unroll
            for (int m = 0; m < 4; ++m) { const f32x4* q = (const f32x4*)(sq + (size_t)(row0 + ai * HALF + m * 16) * 16); const f32x4 a = q[0] + q[1];
                rr[ai][m] = __builtin_amdgcn_rsqf(((a[0] + a[1]) + (a[2] + a[3])) * (1.0f / 512.0f) + 1e-6f); }
#pragma unroll
        for (int ai = 0; ai < 2; ++ai)
#pragma unroll
            for (int m = 0; m < 4; ++m) { const int row = row0 + ai * HALF + m * 16; bf16_t* p = base + (size_t)row * ldc + col0; const float r = rr[ai][m];
#pragma unroll
                for (int bj = 0; bj < 2; ++bj) { const f32x4 v0 = acc[ai][bj][m][0] * r, v1 = acc[ai][bj][m][1] * r;
                    u32x4 w; w.x = cvt_pk_bf16(v0[0], v0[1]); w.y = cvt_pk_bf16(v0[2], v0[3]); w.z = cvt_pk_bf16(v1[0], v1[1]); w.w = cvt_pk_bf16(v1[2], v1[3]);
                    *(u32x4*)(p + bj * HALF) = w; } }
    }
};
struct TailOrder {
    int c, S, K, nks; const char* A; const char* Bt;
    __device__ __forceinline__ void init(const Gemm& g, int S_, int c_) { c = c_; S = S_; K = g.K; nks = g.K / BK / S_; A = (const char*)g.A; Bt = (const char*)g.Bt; }
    __device__ __forceinline__ bool next(int i, Unit& u) const {
        const int xcd = c & 7, j = c >> 3; const size_t ts = (size_t)BM * K * 2;
        if (i == 0) { u.pm = xcd * 4 + (j >> 3); u.pn = j & 7; u.nk = K / BK; u.tag = 0; u.a = A + (size_t)u.pm * ts; u.b = Bt + (size_t)u.pn * ts; return true; }
        if (i == 1) { const int slice = xcd + 8 * (j >> 3); if (slice >= S) return false;
            u.pm = 32; u.pn = j & 7; u.nk = nks; u.tag = 0x200 | slice; u.a = A + 32 * ts + (size_t)slice * nks * (BK * 2); u.b = Bt + (size_t)u.pn * ts + (size_t)slice * nks * (BK * 2); return true; }
        return false;
    }
    __device__ __forceinline__ void a_ready(const Unit&) const {}
    __device__ __forceinline__ void done(const Unit&) const {}
};
struct BranchOrder {
    int c; const char* A0; const char* B0; size_t sA, sB;
    __device__ __forceinline__ bool next(int i, Unit& u) const {
        const int xcd = c & 7, j = c >> 3; const size_t ts = (size_t)BM * 1024 * 2;
        if (i < 3) { u.pm = xcd * 4 + (j >> 3); u.pn = j & 7; u.nk = 16; u.tag = i | (i ? 0x100 : 0);
            u.a = A0 + (size_t)i * sA + (size_t)u.pm * ts; u.b = B0 + (size_t)i * sB + (size_t)u.pn * ts; return true; }
        if (i == 3) { const int bs = xcd + 8 * (j >> 3); if (bs >= 12) return false; const int br = bs >> 2, slice = bs & 3;
            u.pm = 32; u.pn = j & 7; u.nk = 4; u.tag = 0x200 | bs;
            u.a = A0 + (size_t)br * sA + 32 * ts + slice * 512; u.b = B0 + (size_t)br * sB + (size_t)u.pn * ts + slice * 512; return true; }
        return false;
    }
    __device__ __forceinline__ void a_ready(const Unit&) const {}
    __device__ __forceinline__ void done(const Unit&) const {}
};
template <int S2  > struct EpiResidT {
    static constexpr bool PERM = false, AFTER_DRAIN = false; static constexpr float s = 0.5f * S2;
    float* H; float* PART; unsigned long long OUT  ;
    bf16_t* HB; float* SSQ;
    __device__ __forceinline__ void operator()(const f32x4 (&acc)[2][2][4][2], const Unit& u, int wr, int wc, int fr, int fq) const {
        asm volatile("" : "+v"(fr), "+v"(fq));
        if (u.tag & 0x200) {
            float* pb = PART + (size_t)(u.tag & 0xff) * (256 * 2048);
#pragma unroll
            for (int ai = 0; ai < 2; ++ai)
#pragma unroll
                for (int m = 0; m < 4; ++m) { const int lrow = ai * HALF + wr * 64 + m * 16 + fr;
#pragma unroll
                    for (int bj = 0; bj < 2; ++bj)
#pragma unroll
                        for (int n = 0; n < 2; ++n) { const int col = u.pn * BM + bj * HALF + wc * 32 + n * 16 + 4 * fq; *(f32x4*)(pb + (size_t)lrow * 2048 + col) = acc[ai][bj][m][n] * s; } }
            return;
        }
#pragma unroll
        for (int ai = 0; ai < 2; ++ai)
#pragma unroll
            for (int m = 0; m < 4; ++m) { const int row = u.pm * BM + ai * HALF + wr * 64 + m * 16 + fr; const int b = row >= 4224 ? 1 : 0, t = row - b * 4224; float ss = 0.f;
#pragma unroll
                for (int bj = 0; bj < 2; ++bj)
#pragma unroll
                    for (int n = 0; n < 2; ++n) { const int col = u.pn * BM + bj * HALF + wc * 32 + n * 16 + 4 * fq; float* p = H + (size_t)row * 2048 + col;
                        const f32x4 v = *(const f32x4*)p + acc[ai][bj][m][n] * s; *(f32x4*)p = v;
                        if (SSQ != nullptr) { typedef unsigned u32x2 __attribute__((ext_vector_type(2))); u32x2 w; w.x = cvt_pk_bf16(v[0], v[1]); w.y = cvt_pk_bf16(v[2], v[3]); *(u32x2*)(HB + (size_t)row * 2048 + col) = w;
                            ss += (v[0] * v[0] + v[1] * v[1]) + (v[2] * v[2] + v[3] * v[3]); }
                        if (OUT != 0ull && t >= 128) *(__attribute__((address_space(1))) f32x4*)(OUT + ((size_t)(b * 4096 + t - 128) * 2048 + col) * 4) = v; }
                if (SSQ != nullptr) {
                    { float p0 = ss, p1 = ss; asm("s_nop 1\n\tv_permlane16_swap_b32 %0, %1" : "+v"(p0), "+v"(p1)); ss = p0 + p1; p0 = ss; p1 = ss; asm("s_nop 1\n\tv_permlane32_swap_b32 %0, %1" : "+v"(p0), "+v"(p1)); ss = p0 + p1; }
                    if (fq == 0) SSQ[(size_t)row * 32 + 4 * u.pn + wc] = ss; }
                asm volatile("" ::: "memory"); }
    }
};
struct EpiGateR {
    static constexpr bool PERM = false, AFTER_DRAIN = false;
    const bf16_t* G; int ldg; bf16_t* MB; float* PART;
    static __device__ __forceinline__ float em(float x) { return __expf(-fminf(fmaxf(x, -30.f), 30.f)); }
    __device__ __forceinline__ void operator()(f32x4 (&acc)[2][2][4][2], const Unit& u, int wr, int wc, int fr, int fq) const {
        asm volatile("" : "+v"(fr), "+v"(fq));
        typedef unsigned u32x2 __attribute__((ext_vector_type(2)));
        const bool tail = (u.tag & 0x200) != 0; const int br = tail ? ((u.tag & 0xff) >> 2) : (u.tag & 3);
        float* pb = PART + (size_t)(u.tag & 0xff) * (256 * 2048);
        const bool resc = !tail && br < 2;
#pragma unroll
        for (int ai = 0; ai < 2; ++ai) {
            u32x2 gaa[4][2][2], gbb[4][2][2];
#pragma unroll
            for (int m = 0; m < 4; ++m)
#pragma unroll
                for (int bj = 0; bj < 2; ++bj)
#pragma unroll
                    for (int n = 0; n < 2; ++n) { const bf16_t* gp = G + (size_t)(u.pm * BM + ai * HALF + wr * 64 + m * 16 + fr) * ldg + br * 2048 + u.pn * BM + bj * HALF + wc * 32 + n * 16 + 4 * fq;
                        gaa[m][bj][n] = *(const u32x2*)gp; if (resc) gbb[m][bj][n] = *(const u32x2*)(gp + 2048); }
#pragma unroll
            for (int m = 0; m < 4; ++m) { const int lrow = ai * HALF + wr * 64 + m * 16 + fr, row = u.pm * BM + lrow;
#pragma unroll
                for (int bj = 0; bj < 2; ++bj)
#pragma unroll
                    for (int n = 0; n < 2; ++n) { const int col = u.pn * BM + bj * HALF + wc * 32 + n * 16 + 4 * fq;
                        const u32x2 ga = gaa[m][bj][n];
                        f32x4 ea; ea[0] = em(bf_lo(ga.x)); ea[1] = em(bf_hi(ga.x)); ea[2] = em(bf_lo(ga.y)); ea[3] = em(bf_hi(ga.y));
                        if (!resc) {
                            f32x4 v;
#pragma unroll
                            for (int e = 0; e < 4; ++e) v[e] = acc[ai][bj][m][n][e] * __builtin_amdgcn_rcpf(1.0f + ea[e]);
                            if (tail) *(f32x4*)(pb + (size_t)lrow * 2048 + col) = v;
                            else { u32x2 w; w.x = cvt_pk_bf16(v[0], v[1]); w.y = cvt_pk_bf16(v[2], v[3]); *(u32x2*)(MB + (size_t)row * 2048 + col) = w; }
                        } else {
                            const u32x2 gb = gbb[m][bj][n];
                            f32x4 eb; eb[0] = em(bf_lo(gb.x)); eb[1] = em(bf_hi(gb.x)); eb[2] = em(bf_lo(gb.y)); eb[3] = em(bf_hi(gb.y));
#pragma unroll
                            for (int e = 0; e < 4; ++e) acc[ai][bj][m][n][e] *= (1.0f + eb[e]) * __builtin_amdgcn_rcpf(1.0f + ea[e]);
                        } } }
            asm volatile("" ::: "memory"); }
    }
};
struct EpiNull {
    static constexpr bool PERM = true, AFTER_DRAIN = false;
    __device__ __forceinline__ void operator()(const f32x4 (&acc)[2][2][4][2], const Unit& u, int wr, int wc, int fr, int fq) const {
#pragma unroll
        for (int ai = 0; ai < 2; ++ai)
#pragma unroll
            for (int m = 0; m < 4; ++m) asm volatile("" :: "v"(acc[ai][0][m][0]), "v"(acc[ai][0][m][1]), "v"(acc[ai][1][m][0]), "v"(acc[ai][1][m][1]));
    }
};
struct SameTileOrder : StaticOrder {
    __device__ __forceinline__ bool next(int i, Unit& u) const { if (!StaticOrder::next(i, u)) return false; u.pm = 0; u.pn = 0; u.a = A; u.b = Bt; return true; }
};
constexpr int RS_LDS_OFF = 131904;
template <class T, class = void> struct rowsc_of { static constexpr bool v = false; };
template <class T> struct rowsc_of<T, decltype((void)T::ROWSC)> { static constexpr bool v = T::ROWSC; };
template <class Epi, class Sched, bool ALIGN_EPI = false, bool SP2 = false>
__device__ __forceinline__ void gemm_phase(PG8_LAS unsigned char* lds, const Gemm g, const Sched& S, const Epi& E, int tid_in) {
    int tid_ = tid_in; asm volatile("" : "+v"(tid_));
    const int tid = tid_, wid = __builtin_amdgcn_readfirstlane(tid >> 6), lane = tid & 63, wr = wid >> 2, wc = wid & 3, fr = lane & 15, fq = lane >> 4;
    const int K = g.K, LDA = g.lda;
    unsigned voffA[2], voffB[2];
#pragma unroll
    for (int i = 0; i < 2; ++i) { int R, C; stage_rc(tid * 16 + i * 8192, R, C); const int Rb = Epi::PERM ? ((R & ~31) + perm32(R & 31)) : R;
        voffA[i] = (unsigned)(R * LDA + C) * 2u; voffB[i] = (unsigned)(Rb * K + C) * 2u; }
    const size_t kstep = (size_t)(BK * 2);
    const size_t hstep = (size_t)HALF * K * 2, hstepA = (size_t)HALF * LDA * 2;
    const size_t tstep = 2 * hstep;
    const unsigned ldsw = (unsigned)wid * 1024u;
    const int aoff = lds_byte(wr * 64 + fr, fq * 8), boff = lds_byte(wc * 32 + fr, fq * 8);
#define PG8_SA(b, h) (((b) * 2 + (h)) * HTB)
#define PG8_SB(b, h) ((4 + (b) * 2 + (h)) * HTB)
#define PG8_STAGE(bufoff, gbase, voff) do { _Pragma("unroll") for (int _i = 0; _i < 2; ++_i) \
        __builtin_amdgcn_global_load_lds((const unsigned*)((const char*)(gbase) + (voff)[_i]), (PG8_LAS unsigned*)(lds + (bufoff) + ldsw + _i * 8192), 16, 0, 0); } while (0)
#define PG8_LDA(dst, b, h) do { _Pragma("unroll") for (int m = 0; m < 4; ++m) _Pragma("unroll") for (int k = 0; k < 2; ++k) dst[m][k] = *(const PG8_LAS bf16x8*)(lds + PG8_SA(b, h) + aoff + m * 2048 + k * 1024); } while (0)
#define PG8_LDB(dst, b, h) do { _Pragma("unroll") for (int n = 0; n < 2; ++n) _Pragma("unroll") for (int k = 0; k < 2; ++k) dst[n][k] = *(const PG8_LAS bf16x8*)(lds + PG8_SB(b, h) + boff + n * 2048 + k * 1024); } while (0)
#define PG8_MMA(ai, bj, At, Bt) do { __builtin_amdgcn_s_setprio(1); _Pragma("unroll") for (int m = 0; m < 4; ++m) _Pragma("unroll") for (int n = 0; n < 2; ++n) _Pragma("unroll") for (int k = 0; k < 2; ++k) \
        acc[ai][bj][m][n] = __builtin_amdgcn_mfma_f32_16x16x32_bf16(Bt[n][k], At[m][k], acc[ai][bj][m][n], 0, 0, 0); __builtin_amdgcn_s_setprio(0); } while (0)
#define PG8_WAIT_V(n) asm volatile("s_waitcnt vmcnt(" #n ")" ::: "memory")
#define PG8_WAIT_L(n) asm volatile("s_waitcnt lgkmcnt(" #n ")" ::: "memory")
#define PG8_BAR __builtin_amdgcn_s_barrier()
#define PG8_SCHED __builtin_amdgcn_sched_barrier(0)
    Unit cur, nxt; int ui = 0;
    if (!S.next(0, cur)) return;
    f32x4 acc[2][2][4][2];
#pragma unroll
    for (int a = 0; a < 2; ++a)
#pragma unroll
        for (int b = 0; b < 2; ++b)
#pragma unroll
            for (int m = 0; m < 4; ++m)
#pragma unroll
                for (int n = 0; n < 2; ++n) acc[a][b][m][n] = (f32x4){0.f, 0.f, 0.f, 0.f};
    bf16x8 At[4][2], B0[2][2], B1[2][2];
    const char* cA = cur.a; const char* cB = cur.b;
    S.a_ready(cur);
    if constexpr (SP2) {
        PG8_STAGE(PG8_SB(0, 0), cB, voffB); PG8_STAGE(PG8_SB(0, 1), cB + hstep, voffB); PG8_STAGE(PG8_SA(0, 0), cA, voffA); PG8_STAGE(PG8_SA(0, 1), cA + hstepA, voffA);
        if (wr == 1) PG8_BAR;
        PG8_WAIT_V(2); PG8_BAR;
        PG8_STAGE(PG8_SB(1, 0), cB + kstep, voffB); PG8_STAGE(PG8_SA(1, 0), cA + kstep, voffA); PG8_STAGE(PG8_SB(1, 1), cB + hstep + kstep, voffB);
        PG8_WAIT_V(6); PG8_BAR;
    } else {
        PG8_STAGE(PG8_SB(0, 0), cB, voffB); PG8_STAGE(PG8_SA(0, 0), cA, voffA); PG8_STAGE(PG8_SB(0, 1), cB + hstep, voffB); PG8_STAGE(PG8_SA(0, 1), cA + hstepA, voffA);
        if (wr == 1) PG8_BAR;
        PG8_WAIT_V(4); PG8_BAR;
        PG8_STAGE(PG8_SB(1, 0), cB + kstep, voffB); PG8_STAGE(PG8_SA(1, 0), cA + kstep, voffA); PG8_STAGE(PG8_SB(1, 1), cB + hstep + kstep, voffB);
        PG8_WAIT_V(6); PG8_BAR;
    }
    for (;;) {
        const bool has_next = S.next(ui + 1, nxt);
        const char* nA = has_next ? nxt.a : cA; const char* nB = has_next ? nxt.b : cB;
        const int nt = cur.nk;
        if constexpr (rowsc_of<Epi>::v) __builtin_amdgcn_global_load_lds((const unsigned*)(E.SSQ + cur.pm * BM + lane * 4), (PG8_LAS unsigned*)(lds + RS_LDS_OFF + wid * 1024), 16, 0, 0);
        for (int t = 0; t < nt; t += 2) {
            const bool last = (t == nt - 2);
            const char* a1 = cA + (size_t)(t + 1) * kstep;
            const char* a2 = last ? nA : cA + (size_t)(t + 2) * kstep; const char* b2 = last ? nB : cB + (size_t)(t + 2) * kstep;
            const char* a3 = a2 + kstep; const char* b3 = b2 + kstep;
            if (last && has_next) S.a_ready(nxt);
            if constexpr (SP2) {
            PG8_LDB(B0, 0, 0); PG8_LDB(B1, 0, 1); PG8_SCHED; PG8_LDA(At, 0, 0); PG8_STAGE(PG8_SA(1, 1), a1 + hstepA, voffA);
            PG8_WAIT_V(8); PG8_WAIT_L(0); PG8_BAR; PG8_MMA(0, 0, At, B0); PG8_MMA(0, 1, At, B1); PG8_BAR; PG8_SCHED;
            PG8_LDA(At, 0, 1); PG8_STAGE(PG8_SB(0, 0), b2, voffB); PG8_STAGE(PG8_SB(0, 1), b2 + hstep, voffB); PG8_STAGE(PG8_SA(0, 0), a2, voffA);
            PG8_WAIT_V(8); PG8_WAIT_L(0); PG8_BAR; PG8_MMA(1, 0, At, B0); PG8_MMA(1, 1, At, B1); PG8_BAR; PG8_SCHED;
            PG8_LDB(B0, 1, 0); PG8_LDB(B1, 1, 1); PG8_SCHED; PG8_LDA(At, 1, 0); PG8_STAGE(PG8_SA(0, 1), a2 + hstepA, voffA);
            PG8_WAIT_V(8); PG8_WAIT_L(0); PG8_BAR; PG8_MMA(0, 0, At, B0); PG8_MMA(0, 1, At, B1); PG8_BAR; PG8_SCHED;
            PG8_LDA(At, 1, 1); PG8_STAGE(PG8_SB(1, 0), b3, voffB); PG8_STAGE(PG8_SB(1, 1), b3 + hstep, voffB); PG8_STAGE(PG8_SA(1, 0), a3, voffA);
            PG8_WAIT_V(8); PG8_WAIT_L(0); PG8_BAR; PG8_MMA(1, 0, At, B0); PG8_MMA(1, 1, At, B1); PG8_BAR; PG8_SCHED;
            } else {
            PG8_LDB(B0, 0, 0); PG8_SCHED; PG8_LDA(At, 0, 0); PG8_STAGE(PG8_SA(1, 1), a1 + hstepA, voffA);
            PG8_WAIT_L(8); PG8_BAR; PG8_WAIT_L(0); PG8_MMA(0, 0, At, B0); PG8_BAR; PG8_SCHED;
            PG8_LDB(B1, 0, 1); PG8_STAGE(PG8_SB(0, 0), b2, voffB);
            PG8_BAR; PG8_WAIT_L(0); PG8_MMA(0, 1, At, B1); PG8_BAR;
            PG8_LDA(At, 0, 1); PG8_STAGE(PG8_SA(0, 0), a2, voffA);
            PG8_BAR; PG8_WAIT_L(0); PG8_MMA(1, 0, At, B0); PG8_BAR; PG8_SCHED;
            PG8_STAGE(PG8_SB(0, 1), b2 + hstep, voffB);
            PG8_WAIT_V(6); PG8_BAR; PG8_MMA(1, 1, At, B1); PG8_BAR;
            PG8_LDB(B0, 1, 0); PG8_SCHED; PG8_LDA(At, 1, 0); PG8_STAGE(PG8_SA(0, 1), a2 + hstepA, voffA);
            PG8_WAIT_L(8); PG8_BAR; PG8_WAIT_L(0); PG8_MMA(0, 0, At, B0); PG8_BAR; PG8_SCHED;
            PG8_LDB(B1, 1, 1); PG8_STAGE(PG8_SB(1, 0), b3, voffB);
            PG8_BAR; PG8_WAIT_L(0); PG8_MMA(0, 1, At, B1); PG8_BAR;
            PG8_LDA(At, 1, 1); PG8_STAGE(PG8_SA(1, 0), a3, voffA);
            PG8_BAR; PG8_WAIT_L(0); PG8_MMA(1, 0, At, B0); PG8_BAR; PG8_SCHED;
            PG8_STAGE(PG8_SB(1, 1), b3 + hstep, voffB);
            PG8_WAIT_V(6); PG8_BAR; PG8_MMA(1, 1, At, B1); PG8_BAR;
            }
        }
        if constexpr (ALIGN_EPI) { if (wr == 0) PG8_BAR; }
        if constexpr (rowsc_of<Epi>::v) { E(acc, cur, wr, wc, fr, fq, (const PG8_LAS float*)(lds + RS_LDS_OFF + wid * 1024)); S.done(cur); }
        else if constexpr (!Epi::AFTER_DRAIN) { E(acc, cur, wr, wc, fr, fq); S.done(cur); }
        if (!has_next) break;
        if (!(nxt.tag & 0x100)) {
#pragma unroll
        for (int a = 0; a < 2; ++a)
#pragma unroll
            for (int b = 0; b < 2; ++b)
#pragma unroll
                for (int m = 0; m < 4; ++m)
#pragma unroll
                    for (int n = 0; n < 2; ++n) acc[a][b][m][n] = (f32x4){0.f, 0.f, 0.f, 0.f};
        }
        cur = nxt; cA = nA; cB = nB; ++ui;
        if constexpr (ALIGN_EPI) { if (wr == 1) PG8_BAR; }
    }
    PG8_WAIT_V(0);
    if constexpr (!ALIGN_EPI) { if (wr == 0) PG8_BAR; }
    PG8_BAR;
    if constexpr (Epi::AFTER_DRAIN) { E.fused(acc, cur, wr, wc, fr, fq, lds, wid, lane); S.done(cur); }
#undef PG8_SA
#undef PG8_SB
#undef PG8_STAGE
#undef PG8_LDA
#undef PG8_LDB
#undef PG8_MMA
#undef PG8_WAIT_V
#undef PG8_WAIT_L
#undef PG8_BAR
#undef PG8_SCHED
}
}
constexpr int NWAVES = 8;
constexpr int D = 2048, NB = 2, SEQ = 4096, LP = 4224, M = NB * LP, DEPTH = 4, FF = 5632, NGU = 2 * FF, NIN = 11584, NINP = 11776;
constexpr int OQ = 0, OSK = 1024, OSV = 1152, OCQ = 1280, OCKV = 1792, OKR = 2304, ORQ = 2368, ORK = 2880, ORV = 3392, ORG = 4416, OG = 5440;
constexpr int PADR = 112;
constexpr float EPS = 1e-6f, LOG2E = 1.44269504088896f;
constexpr float SWA_QS = 0.125f * LOG2E, MLA_QS = 0.07216878364870322f * LOG2E, RET_KS = 0.08838834764831845f;
constexpr size_t MiB = 1u << 20;
constexpr size_t WS_CTL = 0, CTL_ZERO_BYTES = 1 * MiB;
constexpr size_t WS_C64 = 1 * MiB, WS_S64 = WS_C64 + (size_t)LP * 64 * 4, WS_C32 = WS_S64 + (size_t)LP * 64 * 4, WS_S32 = WS_C32 + (size_t)LP * 32 * 4;
constexpr size_t WS_W = 5 * MiB;
constexpr size_t W_GU1 = WS_W, W_D1 = WS_W + 44 * MiB, W_IN = WS_W + 66 * MiB, W_UQ = WS_W + 112 * MiB, W_UKV = WS_W + 114 * MiB, W_BS = WS_W + 116 * MiB, W_BM = WS_W + 120 * MiB,
                 W_BR = WS_W + 124 * MiB, W_O = WS_W + 128 * MiB, W_GU2 = WS_W + 136 * MiB, W_D2 = WS_W + 180 * MiB;
constexpr size_t WS_H = 208 * MiB, WS_HN = 274 * MiB, WS_ACT = 307 * MiB, WS_Z = 398 * MiB, WS_QS = 588 * MiB, WS_KS = 605 * MiB, WS_CQN = 608 * MiB, WS_CKVN = 617 * MiB,
                 WS_QRAW = 626 * MiB, WS_KVRAW = 651 * MiB, WS_QM = 684 * MiB, WS_KM = 709 * MiB, WS_RQ = 734 * MiB, WS_RK = 743 * MiB, WS_OA = 752 * MiB, WS_OB = 769 * MiB,
                 WS_OC = 786 * MiB, WS_MF = 803 * MiB, WS_MB = 869 * MiB, WS_KVC = 902 * MiB, WS_PREV = 935 * MiB, WS_PART = 952 * MiB, WS_SSQ = 996 * MiB, WS_RS = 1010 * MiB, WS_SSQC = 1011 * MiB, WS_END = 1012 * MiB;
static_assert(WS_S32 + (size_t)LP * 32 * 4 <= WS_W, "rope tables");
static_assert(W_D2 + (size_t)D * FF * 2 <= WS_H && W_IN + (size_t)NINP * D * 2 <= W_UQ && W_GU1 + (size_t)NGU * D * 2 <= W_D1, "weights");
static_assert(WS_Z + (size_t)M * NINP * 2 <= WS_QS && WS_ACT + (size_t)M * FF * 2 <= WS_Z && WS_H + (size_t)M * D * 4 <= WS_HN, "acts");
constexpr int CW_BAR = 4096;
constexpr int RING_BYTES = 131072, LDSCTL_OFF = RING_BYTES, MISC_OFF = LDSCTL_OFF + 320, PTAB_OFF = MISC_OFF + 256, RSL_OFF = PTAB_OFF + 256, LDS_BYTES = 147456;
static_assert(RSL_OFF == pg8::RS_LDS_OFF && RSL_OFF + 8 * 1024 <= LDS_BYTES, "row-scale slots");

#define GAS __attribute__((address_space(1)))
#define LAS __attribute__((address_space(3)))
typedef unsigned short bf16;
typedef unsigned v4u __attribute__((ext_vector_type(4)));
typedef unsigned v2u __attribute__((ext_vector_type(2)));
typedef float f32x4 __attribute__((ext_vector_type(4)));
typedef const GAS float* gfp;
__device__ __forceinline__ gfp in_ptr(LAS unsigned char* lds, int i) { const LAS unsigned* t = (const LAS unsigned*)(lds + PTAB_OFF) + 2 * i; const unsigned lo = __builtin_amdgcn_readfirstlane(t[0]), hi = __builtin_amdgcn_readfirstlane(t[1]); return (gfp)(((unsigned long long)hi << 32) | lo); }
#define LDS_WAIT() asm volatile("s_waitcnt lgkmcnt(0)" ::: "memory")
__device__ __forceinline__ unsigned f2bf(float f) { unsigned u = __builtin_bit_cast(unsigned, f); return (u + 0x7fffu + ((u >> 16) & 1u)) >> 16; }
__device__ __forceinline__ unsigned pk2(float lo, float hi) { unsigned r; asm("v_cvt_pk_bf16_f32 %0, %1, %2" : "=v"(r) : "v"(lo), "v"(hi)); return r; }
__device__ __forceinline__ float bf2f(bf16 v) { return __builtin_bit_cast(float, (unsigned)v << 16); }
__device__ __forceinline__ float blo(unsigned w) { return __builtin_bit_cast(float, w << 16); }
__device__ __forceinline__ float bhi(unsigned w) { return __builtin_bit_cast(float, w & 0xffff0000u); }
__device__ __forceinline__ float ex2(float x) { return __builtin_amdgcn_exp2f(x); }
template <int O> __device__ __forceinline__ float sxor(float v, int lane) {
    if constexpr (O < 32) return __builtin_bit_cast(float, __builtin_amdgcn_ds_swizzle(__builtin_bit_cast(int, v), (O << 10) | 0x1f));
    else return __builtin_bit_cast(float, __builtin_amdgcn_ds_bpermute((lane ^ 32) << 2, __builtin_bit_cast(int, v)));
}
#define SWAP_PAIR(which, v) float r0 = (v), r1 = (v); asm("s_nop 1\n\tv_permlane" #which "_swap_b32 %0, %1" : "+v"(r0), "+v"(r1));
__device__ __forceinline__ float radd16(float v) { SWAP_PAIR(16, v) return r0 + r1; }
__device__ __forceinline__ float radd32(float v) { SWAP_PAIR(32, v) return r0 + r1; }
__device__ __forceinline__ float rmax16(float v) { SWAP_PAIR(16, v) return fmaxf(r0, r1); }
__device__ __forceinline__ float rmax32(float v) { SWAP_PAIR(32, v) return fmaxf(r0, r1); }
template <int CTRL> __device__ __forceinline__ float dpp_f(float v) { return __builtin_bit_cast(float, __builtin_amdgcn_mov_dpp(__builtin_bit_cast(int, v), CTRL, 0xF, 0xF, true)); }
__device__ __forceinline__ float wave_sum(float v, int lane) {
    v += dpp_f<0xB1>(v); v += dpp_f<0x4E>(v); v += dpp_f<0x141>(v); v += dpp_f<0x140>(v); v = radd32(radd16(v));
    return v;
}
template <int N> __device__ __forceinline__ float grp_sum(float v, int lane) {
    static_assert(N == 4 || N == 8, "grp_sum");
    v += dpp_f<0xB1>(v); v += dpp_f<0x4E>(v);
    if constexpr (N == 8) v += dpp_f<0x141>(v);
    return v;
}
#define XB_TMO      128
#define XB_XCNT(j)  (256  + 64 * (j))
#define XB_XSUB(j)  (1280 + 64 * (j))
#define XB_XGEN(j)  (2304 + 64 * (j))
#define XB_TOP      3328
#define XB_TOPGEN   3392
#define XCD_BAR_WORDS 3456
#define XB_SPIN_CAP (1u << 18)

__device__ __forceinline__ unsigned xb_ld(unsigned* p)              { return __hip_atomic_load(p, __ATOMIC_RELAXED, __HIP_MEMORY_SCOPE_AGENT); }
__device__ __forceinline__ unsigned xb_add(unsigned* p, unsigned v) { return __hip_atomic_fetch_add(p, v, __ATOMIC_RELAXED, __HIP_MEMORY_SCOPE_AGENT); }
__device__ __forceinline__ unsigned xb_xcc_id() { return (unsigned)__builtin_amdgcn_s_getreg((3 << 11) | 20) & 0xFu; }
#define XB_SPIN(cond, bar) do { unsigned _sp = 0; while (cond) { __builtin_amdgcn_s_sleep(1); \
    if ((++_sp & 255u) == 0u) { if (xb_ld(&(bar)[XB_TMO])) break; if (_sp > XB_SPIN_CAP) { atomicAdd(&(bar)[XB_TMO], 1u); break; } } } } while (0)

struct XcdBarrier {
    unsigned* bar; unsigned x; int w0; unsigned zz  ;
    volatile LAS unsigned* st;
};

__device__ __forceinline__ XcdBarrier xcd_barrier_post(unsigned* bar, volatile LAS unsigned* st) {
    XcdBarrier b; b.bar = bar; b.x = xb_xcc_id(); b.st = st; b.w0 = __builtin_amdgcn_readfirstlane((int)(threadIdx.x >> 6)); b.zz = 0u;
    if (threadIdx.x == 0) (void)xb_add(&bar[XB_XCNT(b.x)], 1u);
    return b;
}
__device__ __forceinline__ void xcd_barrier_complete(unsigned* bar, unsigned x, unsigned& nloc, unsigned& nx) {
    const unsigned G = gridDim.x * gridDim.y * gridDim.z;
    unsigned sum, cnt, mine, sp = 0u;
    for (;;) {
        sum = 0u; cnt = 0u; mine = 0u;
#pragma unroll
        for (unsigned j = 0; j < 16; ++j) { const unsigned c = xb_ld(&bar[XB_XCNT(j)]); sum += c; cnt += (c > 0u) ? 1u : 0u; mine = (j == x) ? c : mine; }
        if (sum == G) break;
        __builtin_amdgcn_s_sleep(1);
        if ((++sp & 255u) == 0u) { if (xb_ld(&bar[XB_TMO])) break; if (sp > XB_SPIN_CAP) { atomicAdd(&bar[XB_TMO], 1u); break; } }
    }
    nloc = mine > 0u ? mine : 1u; nx = cnt > 0u ? cnt : 1u;
}

__device__ __forceinline__ void xcd_barrier(const XcdBarrier& b) {
    asm volatile("s_waitcnt vmcnt(0)" ::: "memory");
    __syncthreads();
    if (b.w0 == 0 && __builtin_amdgcn_mbcnt_hi(~0u, __builtin_amdgcn_mbcnt_lo(~0u, b.zz)) == 0u) {
        unsigned* bar = b.bar;
        __builtin_amdgcn_s_waitcnt(0);
        unsigned nloc = b.st[0], nx = b.st[1];
        if (nloc == 0u) { xcd_barrier_complete(bar, b.x, nloc, nx); b.st[0] = nloc; b.st[1] = nx; }
        const unsigned old = xb_add(&bar[XB_XSUB(b.x)], 1u);
        const unsigned gen = old / nloc;
        if (old + 1u == (gen + 1u) * nloc) {
            __builtin_amdgcn_fence(__ATOMIC_RELEASE, "agent");
            asm volatile("s_waitcnt vmcnt(0)" ::: "memory");
            const unsigned og = xb_add(&bar[XB_TOP], 1u);
            const unsigned tg = og / nx;
            if (og + 1u == (tg + 1u) * nx) xb_add(&bar[XB_TOPGEN], 1u);
            else XB_SPIN(xb_ld(&bar[XB_TOPGEN]) == tg, bar);
            __builtin_amdgcn_fence(__ATOMIC_ACQUIRE, "agent");
            xb_add(&bar[XB_XGEN(b.x)], 1u);
            asm volatile("s_waitcnt vmcnt(0)" ::: "memory");
        } else {
            XB_SPIN(xb_ld(&bar[XB_XGEN(b.x)]) == gen, bar);
            __builtin_amdgcn_fence(__ATOMIC_ACQUIRE, "agent");
            asm volatile("s_waitcnt vmcnt(0)" ::: "memory");
        }
    }
    __syncthreads();
}
__device__ __forceinline__ void unpack8(const v4u w, float* f) { f[0] = blo(w.x); f[1] = bhi(w.x); f[2] = blo(w.y); f[3] = bhi(w.y); f[4] = blo(w.z); f[5] = bhi(w.z); f[6] = blo(w.w); f[7] = bhi(w.w); }
__device__ __forceinline__ v4u pack8(const float* f) { v4u w; w.x = pk2(f[0], f[1]); w.y = pk2(f[2], f[3]); w.z = pk2(f[4], f[5]); w.w = pk2(f[6], f[7]); return w; }

__device__ __forceinline__ void cvt_item(gfp W, int N, bf16* WT, int Kd, int k0, int n0, int drow0, LAS float* scr, int lane, gfp gk) {
#pragma unroll 8
    for (int i = 0; i < 32; ++i) { const int kk = 2 * i + (lane >> 5); scr[kk * 33 + (lane & 31)] = W[(size_t)(k0 + kk) * N + n0 + (lane & 31)]; }
    const int c = lane & 7;
    f32x4 ga = (f32x4){1.f, 1.f, 1.f, 1.f}, gb = ga;
    if (gk != nullptr) { ga = *(const GAS f32x4*)(gk + k0 + 8 * c); gb = *(const GAS f32x4*)(gk + k0 + 8 * c + 4); }
    LDS_WAIT(); asm volatile("" ::: "memory");
#pragma unroll
    for (int j = 0; j < 4; ++j) { const int n = (lane >> 3) + 8 * j; const LAS float* s = scr + (8 * c) * 33 + n;
        v4u o; o.x = pk2(s[0 * 33] * ga[0], s[1 * 33] * ga[1]); o.y = pk2(s[2 * 33] * ga[2], s[3 * 33] * ga[3]); o.z = pk2(s[4 * 33] * gb[0], s[5 * 33] * gb[1]); o.w = pk2(s[6 * 33] * gb[2], s[7 * 33] * gb[3]);
        *(GAS v4u*)(WT + (size_t)(drow0 + n) * Kd + k0 + 8 * c) = o; }
    LDS_WAIT(); asm volatile("" ::: "memory");
}
__device__ __forceinline__ void cvt_plain(gfp W, int K, int N, bf16* WT, int item, LAS float* scr, int lane, gfp gk) {
    const int nblk = N / 32, kb = item / nblk, nb = item % nblk;
    cvt_item(W, N, WT, K, 64 * kb, 32 * nb, 32 * nb, scr, lane, gk);
}
__device__ __forceinline__ void cvt_gu(gfp W, bf16* WT, int half, int item, LAS float* scr, int lane, gfp gk) {
    const int nblk = FF / 32, kb = item / nblk, nb = item % nblk, n0 = 32 * nb;
    cvt_item(W, FF, WT, D, 64 * kb, n0, 256 * (n0 >> 7) + 128 * half + (n0 & 127), scr, lane, gk);
}

__device__ __forceinline__ void fix_row(float* hrow, bf16* hb, float* rout, int lane, const float* part, int nparts) {
    f32x4 v[8]; float ss = 0.f;
#pragma unroll
    for (int j = 0; j < 8; ++j) v[j] = *(const f32x4*)(hrow + 4 * lane + 256 * j);
    if (part != nullptr) {
        for (int s = 0; s < nparts; ++s) {
#pragma unroll
            for (int j = 0; j < 8; ++j) v[j] = v[j] + *(const f32x4*)(part + (size_t)s * (256 * 2048) + 4 * lane + 256 * j); }
#pragma unroll
        for (int j = 0; j < 8; ++j) *(f32x4*)(hrow + 4 * lane + 256 * j) = v[j];
    }
#pragma unroll
    for (int j = 0; j < 8; ++j) { ss += (v[j].x * v[j].x + v[j].y * v[j].y) + (v[j].z * v[j].z + v[j].w * v[j].w);
        v2u w; w.x = pk2(v[j].x, v[j].y); w.y = pk2(v[j].z, v[j].w); *(v2u*)(hb + 4 * lane + 256 * j) = w; }
    ss = wave_sum(ss, lane);
    if (lane == 0) *rout = __builtin_amdgcn_rsqf(ss * (1.0f / D) + EPS);
}
__device__ __forceinline__ void row_scales(const float* ssq32, float* rout, int gt, int NGT) {
    for (int row = gt; row < 8192; row += NGT) { const f32x4* q = (const f32x4*)(ssq32 + (size_t)row * 32); f32x4 a = q[0];
#pragma unroll
        for (int i = 1; i < 8; ++i) a = a + q[i];
        rout[row] = __builtin_amdgcn_rsqf(((a[0] + a[1]) + (a[2] + a[3])) * (1.0f / D) + EPS); }
}
template <int NP> __device__ __forceinline__ void fix_panel32(float* Hh, bf16* Hb, float* rs_out, const float* part, volatile LAS float* red, int tid, int lane, int wave) {
    for (int lrow = blockIdx.x; lrow < 256; lrow += gridDim.x) {
        const int col = 256 * wave + 4 * lane; const size_t ro = (size_t)(8192 + lrow) * D + col;
        f32x4 v = *(const f32x4*)(Hh + ro); f32x4 p[NP];
#pragma unroll
        for (int s = 0; s < NP; ++s) p[s] = *(const f32x4*)(part + ((size_t)s * 256 + lrow) * 2048 + col);
#pragma unroll
        for (int s = 0; s < NP; ++s) v = v + p[s];
        *(f32x4*)(Hh + ro) = v;
        v2u w; w.x = pk2(v.x, v.y); w.y = pk2(v.z, v.w); *(v2u*)(Hb + ro) = w;
        const float ss = wave_sum((v.x * v.x + v.y * v.y) + (v.z * v.z + v.w * v.w), lane);
        if (lane == 0) red[wave] = ss;
        __syncthreads();
        if (tid == 0) { const float t = ((red[0] + red[1]) + (red[2] + red[3])) + ((red[4] + red[5]) + (red[6] + red[7])); rs_out[lrow] = __builtin_amdgcn_rsqf(t * (1.0f / D) + EPS); }
        __syncthreads();
    }
}
typedef short bf16x8 __attribute__((ext_vector_type(8)));
typedef short s16x4 __attribute__((ext_vector_type(4)));
typedef short v4i16_t __attribute__((ext_vector_type(4)));
__device__ __forceinline__ s16x4 tr_read(LAS const unsigned char* p) { return __builtin_bit_cast(s16x4, __builtin_amdgcn_ds_read_tr16_b64_v4i16((LAS v4i16_t*)p)); }
__device__ __forceinline__ bf16x8 cat4(s16x4 a, s16x4 b) { bf16x8 r; r[0] = a[0]; r[1] = a[1]; r[2] = a[2]; r[3] = a[3]; r[4] = b[0]; r[5] = b[1]; r[6] = b[2]; r[7] = b[3]; return r; }
__device__ __forceinline__ bf16x8 pack_p(const f32x4 a, const f32x4 b) { v4u w; w.x = pk2(a[0], a[1]); w.y = pk2(a[2], a[3]); w.z = pk2(b[0], b[1]); w.w = pk2(b[2], b[3]); return __builtin_bit_cast(bf16x8, w); }
__device__ __forceinline__ float max3f(float a, float b, float c) { float r; asm("v_max3_f32 %0, %1, %2, %3" : "=v"(r) : "v"(a), "v"(b), "v"(c)); return r; }
__device__ __forceinline__ float max8f(const f32x4 a, const f32x4 b) { return max3f(max3f(a[0], a[1], a[2]), max3f(a[3], b[0], b[1]), max3f(b[2], b[3], b[3])); }
#define MFMA16(a, b, c) __builtin_amdgcn_mfma_f32_16x16x32_bf16((a), (b), (c), 0, 0, 0)

__device__ __forceinline__ int pop_unit(unsigned* ctr, volatile LAS unsigned* slot, int tid) {
    __syncthreads();
    if (tid == 0) *slot = __hip_atomic_fetch_add(ctr, 1u, __ATOMIC_RELAXED, __HIP_MEMORY_SCOPE_AGENT);
    __syncthreads();
    return (int)*slot;
}

template <int DQK, int DV, int MODE>
__device__ __forceinline__ void flash_unit(LAS unsigned char* lds, const bf16* Q, int ldq, const bf16* K, int ldk, const bf16* V, int ldv, bf16* O, int ldo, int qb, float sink_l2, int tid) {
    constexpr int SK = DQK * 2 + 16, SV = DV * 2 + 16, KB = 64 * SK, VB = 64 * SV, BUF = KB + VB;
    constexpr int KCH = DQK / 8, VCH = DV / 8, NKC = 64 * KCH / 512, NVC = 64 * VCH / 512, NKS = DQK / 32, NDV = DV / 16;
    static_assert(64 * KCH % 512 == 0 && 64 * VCH % 512 == 0 && 2 * BUF <= RING_BYTES, "flash tile geometry");
    const int lane = tid & 63, w = __builtin_amdgcn_readfirstlane(tid >> 6), g = lane >> 4, c16 = lane & 15;
    const int q0 = qb * 128, qrow = q0 + 16 * w + c16;
    const int first2 = MODE == 0 ? 2 : ((2 * qb - 2) > 2 ? (2 * qb - 2) : 2);
    const int nt = MODE == 0 ? 2 * qb + 1 : 1 + ((2 * qb + 2 - first2) > 0 ? (2 * qb + 2 - first2) : 0);
#define FL_KT(it) ((it) == 0 ? 1 : first2 + (it) - 1)
    bf16x8 qf[NKS];
#pragma unroll
    for (int ks = 0; ks < NKS; ++ks) qf[ks] = *(const bf16x8*)(Q + (size_t)qrow * ldq + 32 * ks + 8 * g);
    v4u kr[2][NKC], vr[2][NVC];
#define FL_LOAD(kt, P) do { const int key0_ = 64 * (kt); \
        _Pragma("unroll") for (int j = 0; j < NKC; ++j) { const int c = tid + 512 * j, r = c / KCH, cc = c % KCH; kr[P][j] = *(const v4u*)(K + (size_t)(key0_ + r) * ldk + cc * 8); } \
        _Pragma("unroll") for (int j = 0; j < NVC; ++j) { const int c = tid + 512 * j, r = c / VCH, cc = c % VCH; vr[P][j] = *(const v4u*)(V + (size_t)(key0_ + r) * ldv + cc * 8); } } while (0)
#define FL_STORE(buf, P) do { \
        _Pragma("unroll") for (int j = 0; j < NKC; ++j) { const int c = tid + 512 * j, r = c / KCH, cc = c % KCH; *(LAS v4u*)(lds + (buf) * BUF + r * SK + cc * 16) = kr[P][j]; } \
        _Pragma("unroll") for (int j = 0; j < NVC; ++j) { const int c = tid + 512 * j, r = c / VCH, cc = c % VCH; *(LAS v4u*)(lds + (buf) * BUF + KB + r * SV + cc * 16) = vr[P][j]; } } while (0)
    f32x4 acc_o[NDV];
#pragma unroll
    for (int n = 0; n < NDV; ++n) acc_o[n] = (f32x4){0.f, 0.f, 0.f, 0.f};
    float m = -1e30f, l = 0.f;
    FL_LOAD(FL_KT(0), 0);
    if (nt > 1) FL_LOAD(FL_KT(1), 1);
    for (int it2 = 0; it2 < nt; it2 += 2) {
#pragma unroll
        for (int P = 0; P < 2; ++P) {
        const int it = it2 + P;
        if (it < nt) {
        const int buf = P, key0 = 64 * FL_KT(it);
        FL_STORE(buf, P);
        __syncthreads();
        if (it + 2 < nt) FL_LOAD(FL_KT(it + 2), P);
        const LAS unsigned char* kb = lds + buf * BUF; const LAS unsigned char* vb = kb + KB;
        f32x4 s[4];
#pragma unroll
        for (int t = 0; t < 4; ++t) { s[t] = (f32x4){0.f, 0.f, 0.f, 0.f};
#pragma unroll
            for (int ks = 0; ks < NKS; ++ks) { const bf16x8 kf = *(const LAS bf16x8*)(kb + (16 * t + c16) * SK + (32 * ks + 8 * g) * 2); s[t] = MFMA16(kf, qf[ks], s[t]); } }
        const bool need_mask = MODE == 1 || key0 < 128 || key0 + 63 > q0 + 16 * w;
        if (need_mask) {
#pragma unroll
            for (int t = 0; t < 4; ++t)
#pragma unroll
                for (int r = 0; r < 4; ++r) { const int k = key0 + 16 * t + 4 * g + r;
                    bool vis = k >= PADR && k <= qrow; if (MODE == 1) vis = vis && (qrow - k < 128 || k < 128);
                    if (!vis) s[t][r] = -1e30f; }
        }
        float mx = fmaxf(fmaxf(fmaxf(s[0][0], s[0][1]), fmaxf(s[0][2], s[0][3])), fmaxf(fmaxf(s[1][0], s[1][1]), fmaxf(s[1][2], s[1][3])));
        mx = fmaxf(mx, fmaxf(fmaxf(fmaxf(s[2][0], s[2][1]), fmaxf(s[2][2], s[2][3])), fmaxf(fmaxf(s[3][0], s[3][1]), fmaxf(s[3][2], s[3][3]))));
        mx = rmax32(rmax16(mx));
        const float mn = fmaxf(m, mx), al = ex2(m - mn); m = mn;
        float ps = 0.f;
#pragma unroll
        for (int t = 0; t < 4; ++t)
#pragma unroll
            for (int r = 0; r < 4; ++r) { s[t][r] = ex2(s[t][r] - mn); ps += s[t][r]; }
        l = l * al + ps;
        if (!__all(al == 1.0f)) {
#pragma unroll
            for (int n = 0; n < NDV; ++n) acc_o[n] = acc_o[n] * al; }
#pragma unroll
        for (int tp = 0; tp < 2; ++tp) { const bf16x8 pf = pack_p(s[2 * tp], s[2 * tp + 1]);
            const LAS unsigned char* v0 = vb + (32 * tp + 4 * g + (c16 >> 2)) * SV + (4 * (c16 & 3)) * 2;
#pragma unroll
            for (int n = 0; n < NDV; ++n) { const bf16x8 vf = cat4(tr_read(v0 + n * 32), tr_read(v0 + 16 * SV + n * 32)); acc_o[n] = MFMA16(vf, pf, acc_o[n]); } }
        } }
    }
    l = radd32(radd16(l));
    if (MODE == 1) l += ex2(sink_l2 - m);
    const float inv = 1.0f / l;
#pragma unroll
    for (int n = 0; n < NDV; ++n) { v2u o; o.x = pk2(acc_o[n][0] * inv, acc_o[n][1] * inv); o.y = pk2(acc_o[n][2] * inv, acc_o[n][3] * inv); *(v2u*)(O + (size_t)qrow * ldo + 16 * n + 4 * g) = o; }
#undef FL_KT
#undef FL_LOAD
#undef FL_STORE
}

template <int NH>
__device__ __forceinline__ void swa_gqa_unit(LAS unsigned char* lds, const bf16* Q, const bf16* K, int ldk, const bf16* V, int ldv, bf16* O, int qb, gfp sinks, int tid) {
    constexpr int SK = 64 * 2 + 16, SV = 64 * 2 + 32  , KB = 64 * SK, VB = 64 * SV, BUF = KB + VB;
    const int lane = tid & 63, w = __builtin_amdgcn_readfirstlane(tid >> 6), g = lane >> 4, c16 = lane & 15;
    const int q0 = qb * 128, qrow = q0 + 16 * w + c16;
    const int first2 = (2 * qb - 2) > 2 ? (2 * qb - 2) : 2;
    const int nt = 1 + ((2 * qb + 2 - first2) > 0 ? (2 * qb + 2 - first2) : 0);
#define FL_KT(it) ((it) == 0 ? 1 : first2 + (it) - 1)
    bf16x8 qf[NH][2];
#pragma unroll
    for (int hh = 0; hh < NH; ++hh)
#pragma unroll
        for (int ks = 0; ks < 2; ++ks) qf[hh][ks] = *(const bf16x8*)(Q + (size_t)qrow * 1024 + hh * 64 + 32 * ks + 8 * g);
    f32x4 acc_o[NH][4]; float m[NH], l[NH];
#pragma unroll
    for (int hh = 0; hh < NH; ++hh) { m[hh] = -1e30f; l[hh] = 0.f;
#pragma unroll
        for (int n = 0; n < 4; ++n) acc_o[hh][n] = (f32x4){0.f, 0.f, 0.f, 0.f}; }
    const int r_ = tid >> 3, cc_ = tid & 7;
    v4u kr, vr;
    const unsigned kofs = (unsigned)((r_ * ldk + cc_ * 8) * 2), vofs = (unsigned)((r_ * ldv + cc_ * 8) * 2);
#define SW_LOAD(kt) do { kr = *(const v4u*)((const char*)K + (size_t)(64 * (kt)) * ldk * 2 + kofs); vr = *(const v4u*)((const char*)V + (size_t)(64 * (kt)) * ldv * 2 + vofs); } while (0)
    SW_LOAD(FL_KT(0));
    for (int it = 0; it < nt; ++it) {
        const int buf = it & 1, key0 = 64 * FL_KT(it);
        *(LAS v4u*)(lds + buf * BUF + r_ * SK + cc_ * 16) = kr; *(LAS v4u*)(lds + buf * BUF + KB + r_ * SV + cc_ * 16) = vr;
        __syncthreads();
        if (it + 1 < nt) SW_LOAD(FL_KT(it + 1));
        const LAS unsigned char* kb = lds + buf * BUF; const LAS unsigned char* vb = kb + KB;
        const bool need_mask = !(key0 >= 128 && key0 + 63 <= q0 + 16 * w && q0 + 16 * w + 15 - key0 < 128);
#pragma unroll
        for (int hh = 0; hh < NH; ++hh) {
            f32x4 s[4];
#pragma unroll
            for (int t = 0; t < 4; ++t) { s[t] = (f32x4){0.f, 0.f, 0.f, 0.f};
#pragma unroll
                for (int ks = 0; ks < 2; ++ks) { const bf16x8 kf = *(const LAS bf16x8*)(kb + (16 * t + c16) * SK + (32 * ks + 8 * g) * 2); s[t] = MFMA16(kf, qf[hh][ks], s[t]); } }
            if (need_mask)
#pragma unroll
            for (int t = 0; t < 4; ++t)
#pragma unroll
                for (int r = 0; r < 4; ++r) { const int k = key0 + 16 * t + 4 * g + r;
                    const bool vis = (k >= PADR) & (k <= qrow) & (((qrow - k) < 128) | (k < 128)); s[t][r] = vis ? s[t][r] : -1e30f; }
            float mx; { const float ma = max8f(s[0], s[1]), mb = max8f(s[2], s[3]); mx = max3f(ma, mb, mb); }
            if (!__all(mx <= m[hh] + 8.0f)) {
                mx = rmax32(rmax16(mx));
                const float mn = fmaxf(m[hh], mx), al = ex2(m[hh] - mn); m[hh] = mn; l[hh] *= al;
#pragma unroll
                for (int n = 0; n < 4; ++n) acc_o[hh][n] = acc_o[hh][n] * al; }
            const float mc = m[hh]; float ps = 0.f;
#pragma unroll
            for (int t = 0; t < 4; ++t)
#pragma unroll
                for (int r = 0; r < 4; ++r) { s[t][r] = ex2(s[t][r] - mc); ps += s[t][r]; }
            l[hh] += ps;
#pragma unroll
            for (int tp = 0; tp < 2; ++tp) { const bf16x8 pf = pack_p(s[2 * tp], s[2 * tp + 1]); const LAS unsigned char* v0 = vb + (32 * tp + 4 * g + (c16 >> 2)) * SV + (4 * (c16 & 3)) * 2;
#pragma unroll
                for (int n = 0; n < 4; ++n) { const bf16x8 vf = cat4(tr_read(v0 + n * 32), tr_read(v0 + 16 * SV + n * 32)); acc_o[hh][n] = MFMA16(vf, pf, acc_o[hh][n]); } }
        }
    }
#pragma unroll
    for (int hh = 0; hh < NH; ++hh) {
        float lt = l[hh]; lt = radd32(radd16(lt));
        lt += ex2(sinks[hh] * LOG2E - m[hh]);
        const float inv = 1.0f / lt;
#pragma unroll
        for (int n = 0; n < 4; ++n) { v2u o; o.x = pk2(acc_o[hh][n][0] * inv, acc_o[hh][n][1] * inv); o.y = pk2(acc_o[hh][n][2] * inv, acc_o[hh][n][3] * inv); *(v2u*)(O + (size_t)qrow * 1024 + hh * 64 + 16 * n + 4 * g) = o; }
    }
#undef SW_LOAD
#undef FL_KT
}

template <int DQK, int DV, int MODE, int PRB = 0  >
__device__ __forceinline__ void flash_unit2(LAS unsigned char* lds, const bf16* Q, int ldq, const bf16* K, int ldk, const bf16* V, int ldv, bf16* O, int ldo, int qb, float sink_l2, int tid) {
    constexpr int SK = DQK * 2 + 16, SV = DV * 2 + 32  , KB = 64 * SK, VB = 64 * SV, BUF = KB + VB;
    constexpr int KCH = DQK / 8, VCH = DV / 8, NKC = 64 * KCH / 512, NVC = 64 * VCH / 512, NKS = DQK / 32, NDV = DV / 16, NEX = 2 * NDV * 4 + 4;
    static_assert(64 * KCH % 512 == 0 && 64 * VCH % 512 == 0 && 2 * BUF <= RING_BYTES && 4 * NEX * 256 <= RING_BYTES, "flash tile geometry");
    const int lane = tid & 63, w = __builtin_amdgcn_readfirstlane(tid >> 6), qw = w & 3, kh = w >> 2, g = lane >> 4, c16 = lane & 15;
    const int q0 = qb * 128, qbase = q0 + 32 * qw;
    const int first2 = MODE == 0 ? 2 : ((2 * qb - 2) > 2 ? (2 * qb - 2) : 2);
    const int nt = MODE == 0 ? 2 * qb + 1 : 1 + ((2 * qb + 2 - first2) > 0 ? (2 * qb + 2 - first2) : 0);
#define FL_KT(it) ((it) == 0 ? 1 : first2 + (it) - 1)
    bf16x8 qf[2][NKS];
#pragma unroll
    for (int sb = 0; sb < 2; ++sb)
#pragma unroll
        for (int ks = 0; ks < NKS; ++ks) qf[sb][ks] = *(const bf16x8*)(Q + (size_t)(qbase + 16 * sb + c16) * ldq + 32 * ks + 8 * g);
    v4u kr[2][NKC], vr[2][NVC];
    unsigned kofs[NKC], vofs[NVC];
#pragma unroll
    for (int j = 0; j < NKC; ++j) { const int c = tid + 512 * j; kofs[j] = (unsigned)(((c / KCH) * ldk + (c % KCH) * 8) * 2); }
#pragma unroll
    for (int j = 0; j < NVC; ++j) { const int c = tid + 512 * j; vofs[j] = (unsigned)(((c / VCH) * ldv + (c % VCH) * 8) * 2); }
#define FL_LOAD(kt, P) do { const char* kb_ = (const char*)K + (size_t)(64 * (kt)) * ldk * 2; const char* vb_ = (const char*)V + (size_t)(64 * (kt)) * ldv * 2; \
        _Pragma("unroll") for (int j = 0; j < NKC; ++j) kr[P][j] = *(const v4u*)(kb_ + kofs[j]); \
        _Pragma("unroll") for (int j = 0; j < NVC; ++j) vr[P][j] = *(const v4u*)(vb_ + vofs[j]); } while (0)
#define FL_STORE(buf, P) do { \
        _Pragma("unroll") for (int j = 0; j < NKC; ++j) { const int c = tid + 512 * j, r = c / KCH, cc = c % KCH; *(LAS v4u*)(lds + (buf) * BUF + r * SK + cc * 16) = kr[P][j]; } \
        _Pragma("unroll") for (int j = 0; j < NVC; ++j) { const int c = tid + 512 * j, r = c / VCH, cc = c % VCH; *(LAS v4u*)(lds + (buf) * BUF + KB + r * SV + cc * 16) = vr[P][j]; } } while (0)
    f32x4 acc_o[2][NDV];
#pragma unroll
    for (int sb = 0; sb < 2; ++sb)
#pragma unroll
        for (int n = 0; n < NDV; ++n) acc_o[sb][n] = (f32x4){0.f, 0.f, 0.f, 0.f};
    float m[2] = {-1e30f, -1e30f}, l[2] = {0.f, 0.f};
    FL_LOAD(FL_KT(0), 0);
    if (nt > 1) FL_LOAD(FL_KT(1), 1);
    for (int it2 = 0; it2 < nt; it2 += 2) {
#pragma unroll
        for (int P = 0; P < 2; ++P) {
        const int it = it2 + P;
        if (it < nt) {
        const int buf = P, key0 = 64 * FL_KT(it) + 32 * kh;
        FL_STORE(buf, P);
        __syncthreads();
        if (it + 2 < nt) FL_LOAD(FL_KT(it + 2), P);
        const LAS unsigned char* kb = lds + buf * BUF + (32 * kh) * SK; const LAS unsigned char* vb = lds + buf * BUF + KB + (32 * kh) * SV;
        f32x4 s[2][2];
#pragma unroll
        for (int sb = 0; sb < 2; ++sb)
#pragma unroll
            for (int t = 0; t < 2; ++t) s[sb][t] = (f32x4){0.f, 0.f, 0.f, 0.f};
        if (PRB < 2) {
        {
#define FL_RK(e) (*(const LAS bf16x8*)(kb + (16 * ((e) / NKS) + c16) * SK + (32 * ((e) % NKS) + 8 * g) * 2))
            bf16x8 kq[3]; kq[0] = FL_RK(0); kq[1] = FL_RK(1);
#pragma unroll
            for (int e = 0; e < 2 * NKS; ++e) { if (e + 2 < 2 * NKS) kq[(e + 2) % 3] = FL_RK(e + 2);
                s[0][e / NKS] = MFMA16(kq[e % 3], qf[0][e % NKS], s[0][e / NKS]); s[1][e / NKS] = MFMA16(kq[e % 3], qf[1][e % NKS], s[1][e / NKS]);
                }
#undef FL_RK
        }
        }
        const bool need_mask = PRB == 0 && (MODE == 1 || key0 < 128 || key0 + 31 > qbase);
        bf16x8 pf[2];
#pragma unroll
        for (int sb = 0; sb < 2; ++sb) {
            const int qrow = qbase + 16 * sb + c16;
            if (need_mask) {
#pragma unroll
                for (int t = 0; t < 2; ++t)
#pragma unroll
                    for (int r = 0; r < 4; ++r) { const int k = key0 + 16 * t + 4 * g + r;
                        bool vis = k >= PADR && k <= qrow; if (MODE == 1) vis = vis && (qrow - k < 128 || k < 128);
                        if (!vis) s[sb][t][r] = -1e30f; }
            }
            if (PRB == 0) {
            float mx = max8f(s[sb][0], s[sb][1]);
            if (!__all(mx <= m[sb] + 8.0f)) {
                mx = rmax32(rmax16(mx));
                const float mn = fmaxf(m[sb], mx), al = ex2(m[sb] - mn); m[sb] = mn; l[sb] *= al;
#pragma unroll
                for (int n = 0; n < NDV; ++n) acc_o[sb][n] = acc_o[sb][n] * al; }
            const float mc = m[sb]; float ps = 0.f;
#pragma unroll
            for (int t = 0; t < 2; ++t)
#pragma unroll
                for (int r = 0; r < 4; ++r) { s[sb][t][r] = ex2(s[sb][t][r] - mc); ps += s[sb][t][r]; }
            l[sb] += ps;
            }
            pf[sb] = pack_p(s[sb][0], s[sb][1]);
        }
        const LAS unsigned char* v0 = vb + (4 * g + (c16 >> 2)) * SV + (4 * (c16 & 3)) * 2;
        if (PRB < 2) {
#define FL_RV(n) cat4(tr_read(v0 + (n) * 32), tr_read(v0 + 16 * SV + (n) * 32))
            bf16x8 vq[3]; vq[0] = FL_RV(0); vq[1] = FL_RV(1);
#pragma unroll
            for (int n = 0; n < NDV; ++n) { if (n + 2 < NDV) vq[(n + 2) % 3] = FL_RV(n + 2);
                acc_o[0][n] = MFMA16(vq[n % 3], pf[0], acc_o[0][n]); acc_o[1][n] = MFMA16(vq[n % 3], pf[1], acc_o[1][n]);
                }
#undef FL_RV
        }
        } }
    }
#pragma unroll
    for (int sb = 0; sb < 2; ++sb) { l[sb] = radd32(radd16(l[sb])); }
    __syncthreads();
    LAS float* ex = (LAS float*)lds + (size_t)qw * NEX * 64 + lane;
    if (kh == 1) {
#pragma unroll
        for (int sb = 0; sb < 2; ++sb) {
#pragma unroll
            for (int n = 0; n < NDV; ++n)
#pragma unroll
                for (int r = 0; r < 4; ++r) ex[((sb * NDV + n) * 4 + r) * 64] = acc_o[sb][n][r];
            ex[(2 * NDV * 4 + sb) * 64] = m[sb]; ex[(2 * NDV * 4 + 2 + sb) * 64] = l[sb]; }
    }
    __syncthreads();
    if (kh == 0) {
#pragma unroll
        for (int sb = 0; sb < 2; ++sb) {
            const float mb = ex[(2 * NDV * 4 + sb) * 64], lb = ex[(2 * NDV * 4 + 2 + sb) * 64];
            const float mt = fmaxf(m[sb], mb), fa = ex2(m[sb] - mt), fb = ex2(mb - mt);
            float lt = l[sb] * fa + lb * fb;
            if (MODE == 1) lt += ex2(sink_l2 - mt);
            const float inv = 1.0f / lt; const int qrow = qbase + 16 * sb + c16;
#pragma unroll
            for (int n = 0; n < NDV; ++n) { float o[4];
#pragma unroll
                for (int r = 0; r < 4; ++r) o[r] = (acc_o[sb][n][r] * fa + ex[((sb * NDV + n) * 4 + r) * 64] * fb) * inv;
                v2u ov; ov.x = pk2(o[0], o[1]); ov.y = pk2(o[2], o[3]); *(v2u*)(O + (size_t)qrow * ldo + 16 * n + 4 * g) = ov; }
        }
    }
#undef FL_KT
#undef FL_LOAD
#undef FL_STORE
}

__device__ __forceinline__ void ret_kv_unit(LAS unsigned char* lds, const bf16* Zk  , const bf16* Vp, float* KVC, float lg2  ,
                                            int t0  , const float* C64, const float* S64, int tid) {
    constexpr int SKk = 128 * 2 + 32, SVv = 256 * 2 + 32  , KOFF = 0, VOFF = 128 * SKk;
    const int lane = tid & 63, w = __builtin_amdgcn_readfirstlane(tid >> 6), g = lane >> 4, c16 = lane & 15;
#pragma unroll
    for (int j = 0; j < 2; ++j) { const int it = tid + 512 * j, r = it >> 3, cc = it & 7, t = t0 + r; float x1[8], x2[8];
        unpack8(*(const v4u*)(Zk + (size_t)r * NINP + cc * 8), x1); unpack8(*(const v4u*)(Zk + (size_t)r * NINP + 64 + cc * 8), x2);
        const f32x4 ca = *(const f32x4*)(C64 + t * 64 + cc * 8), cb = *(const f32x4*)(C64 + t * 64 + cc * 8 + 4), sa = *(const f32x4*)(S64 + t * 64 + cc * 8), sb = *(const f32x4*)(S64 + t * 64 + cc * 8 + 4);
        const float z = (t >= PADR ? RET_KS : 0.f) * ex2((float)(127 - r) * lg2); float o1[8], o2[8];
#pragma unroll
        for (int i = 0; i < 8; ++i) { const float c = i < 4 ? ca[i & 3] : cb[i & 3], sn = i < 4 ? sa[i & 3] : sb[i & 3]; o1[i] = (x1[i] * c - x2[i] * sn) * z; o2[i] = (x2[i] * c + x1[i] * sn) * z; }
        *(LAS v4u*)(lds + KOFF + r * SKk + cc * 16) = pack8(o1); *(LAS v4u*)(lds + KOFF + r * SKk + 128 + cc * 16) = pack8(o2); }
#pragma unroll
    for (int j = 0; j < 8; ++j) { const int c = tid + 512 * j, r = c >> 5, cc = c & 31; *(LAS v4u*)(lds + VOFF + r * SVv + cc * 16) = *(const v4u*)(Vp + (size_t)r * NINP + cc * 8); }
    __syncthreads();
    f32x4 acc[2][8];
#pragma unroll
    for (int i = 0; i < 2; ++i)
#pragma unroll
        for (int j = 0; j < 8; ++j) acc[i][j] = (f32x4){0.f, 0.f, 0.f, 0.f};
    const int roff = 8 * g + (c16 >> 2), coff = 4 * (c16 & 3);
#pragma unroll
    for (int ks = 0; ks < 4; ++ks) {
        bf16x8 af[2];
#pragma unroll
        for (int i = 0; i < 2; ++i) { const LAS unsigned char* p = lds + VOFF + (32 * ks + roff) * SVv + (16 * (2 * w + i) + coff) * 2; af[i] = cat4(tr_read(p), tr_read(p + 4 * SVv)); }
#pragma unroll
        for (int j = 0; j < 8; ++j) { const LAS unsigned char* p = lds + KOFF + (32 * ks + roff) * SKk + (16 * j + coff) * 2; const bf16x8 bfr = cat4(tr_read(p), tr_read(p + 4 * SKk));
#pragma unroll
            for (int i = 0; i < 2; ++i) acc[i][j] = MFMA16(af[i], bfr, acc[i][j]); }
    }
#pragma unroll
    for (int i = 0; i < 2; ++i)
#pragma unroll
        for (int j = 0; j < 8; ++j) *(f32x4*)(KVC + (size_t)(16 * j + c16) * 256 + 16 * (2 * w + i) + 4 * g) = acc[i][j];
}
__device__ __forceinline__ void ret_out_unit(LAS unsigned char* lds, const bf16* Qp, const bf16* Kp, const bf16* Vp, const bf16* Sp  , const bf16* Gp  ,
                                             gfp gn  , bf16* Op, float lg2, int tid) {
    constexpr int SKk = 128 * 2 + 16, SVv = 256 * 2 + 32, KOFF = 0, VOFF = 128 * SKk;
    const int lane = tid & 63, w = __builtin_amdgcn_readfirstlane(tid >> 6), g = lane >> 4, c16 = lane & 15, ql = 16 * w + c16;
#pragma unroll
    for (int j = 0; j < 4; ++j) { const int c = tid + 512 * j, r = c >> 4, cc = c & 15; *(LAS v4u*)(lds + KOFF + r * SKk + cc * 16) = *(const v4u*)(Kp + (size_t)r * 512 + cc * 8); }
#pragma unroll
    for (int j = 0; j < 8; ++j) { const int c = tid + 512 * j, r = c >> 5, cc = c & 31; *(LAS v4u*)(lds + VOFF + r * SVv + cc * 16) = *(const v4u*)(Vp + (size_t)r * NINP + cc * 8); }
    bf16x8 qf[4];
#pragma unroll
    for (int ks = 0; ks < 4; ++ks) qf[ks] = *(const bf16x8*)(Qp + (size_t)ql * 512 + 32 * ks + 8 * g);
    v2u gwv[16];
#pragma unroll
    for (int n = 0; n < 16; ++n) gwv[n] = *(const v2u*)(Gp + (size_t)ql * NINP + 16 * n + 4 * g);
    __syncthreads();
    f32x4 acc_o[16];
#pragma unroll
    for (int n = 0; n < 16; ++n) acc_o[n] = (f32x4){0.f, 0.f, 0.f, 0.f};
#pragma unroll
    for (int tp = 0; tp < 4; ++tp) {
        if (2 * tp <= w) {
            f32x4 s[2];
#pragma unroll
            for (int u = 0; u < 2; ++u) { const int t = 2 * tp + u; s[u] = (f32x4){0.f, 0.f, 0.f, 0.f};
#pragma unroll
                for (int ks = 0; ks < 4; ++ks) { const bf16x8 kf = *(const LAS bf16x8*)(lds + KOFF + (16 * t + c16) * SKk + (32 * ks + 8 * g) * 2); s[u] = MFMA16(kf, qf[ks], s[u]); }
#pragma unroll
                for (int r = 0; r < 4; ++r) { const int d = ql - (16 * t + 4 * g + r); s[u][r] = d >= 0 ? s[u][r] * ex2((float)d * lg2) : 0.f; } }
            const bf16x8 pf = pack_p(s[0], s[1]);
            const LAS unsigned char* v0 = lds + VOFF + (32 * tp + 4 * g + (c16 >> 2)) * SVv + (4 * (c16 & 3)) * 2;
#pragma unroll
            for (int n = 0; n < 16; ++n) { const bf16x8 vf = cat4(tr_read(v0 + n * 32), tr_read(v0 + 16 * SVv + n * 32)); acc_o[n] = MFMA16(vf, pf, acc_o[n]); }
        }
    }
    __syncthreads();
#pragma unroll
    for (int j = 0; j < 8; ++j) { const int c = tid + 512 * j, r = c >> 5, cc = c & 31; *(LAS v4u*)(lds + VOFF + r * SVv + cc * 16) = *(const v4u*)(Sp + (size_t)r * 256 + cc * 8); }
    { const float xi = ex2((float)(ql + 1) * lg2);
#pragma unroll
      for (int ks = 0; ks < 4; ++ks) { float f[8]; unpack8(__builtin_bit_cast(v4u, qf[ks]), f);
#pragma unroll
          for (int i = 0; i < 8; ++i) f[i] *= xi;
          qf[ks] = __builtin_bit_cast(bf16x8, pack8(f)); } }
    __syncthreads();
    const int roff = 8 * g + (c16 >> 2), coff = 4 * (c16 & 3);
#pragma unroll
    for (int ks = 0; ks < 4; ++ks) {
        const LAS unsigned char* p0 = lds + VOFF + (32 * ks + roff) * SVv + coff * 2;
#pragma unroll
        for (int n = 0; n < 16; ++n) { const bf16x8 sf = cat4(tr_read(p0 + n * 32), tr_read(p0 + 4 * SVv + n * 32)); acc_o[n] = MFMA16(sf, qf[ks], acc_o[n]); }
    }
    float sum = 0.f;
#pragma unroll
    for (int n = 0; n < 16; ++n) sum += (acc_o[n][0] + acc_o[n][1]) + (acc_o[n][2] + acc_o[n][3]);
    sum = radd32(radd16(sum));
    const float mu = sum * (1.0f / 256.0f); float qq = 0.f;
#pragma unroll
    for (int n = 0; n < 16; ++n) { acc_o[n] = acc_o[n] - mu; qq += (acc_o[n][0] * acc_o[n][0] + acc_o[n][1] * acc_o[n][1]) + (acc_o[n][2] * acc_o[n][2] + acc_o[n][3] * acc_o[n][3]); }
    qq = radd32(radd16(qq));
    const float rs = rsqrtf(qq * (1.0f / 256.0f) + EPS);
    f32x4 ggv[16];
#pragma unroll
    for (int n = 0; n < 16; ++n) ggv[n] = *(const GAS f32x4*)(gn + 16 * n + 4 * g);
#pragma unroll
    for (int n = 0; n < 16; ++n) { const int dv = 16 * n + 4 * g; const f32x4 gg = ggv[n]; const v2u gw = gwv[n];
        const float t0 = blo(gw.x), t1 = bhi(gw.x), t2 = blo(gw.y), t3 = bhi(gw.y);
        v2u o; o.x = pk2(acc_o[n][0] * rs * gg[0] * (t0 * __builtin_amdgcn_rcpf(1.0f + __expf(-t0))), acc_o[n][1] * rs * gg[1] * (t1 * __builtin_amdgcn_rcpf(1.0f + __expf(-t1))));
        o.y = pk2(acc_o[n][2] * rs * gg[2] * (t2 * __builtin_amdgcn_rcpf(1.0f + __expf(-t2))), acc_o[n][3] * rs * gg[3] * (t3 * __builtin_amdgcn_rcpf(1.0f + __expf(-t3))));
        *(v2u*)(Op + (size_t)ql * 1024 + dv) = o; }
}
#ifndef FLASH_MLA
#define FLASH_MLA flash_unit2
#endif
#ifndef FLASH_SWA
#define FLASH_SWA flash_unit
#endif
#ifndef REP_REST
#define REP_REST 1
#endif
#ifndef REP_GU
#define REP_GU 1
#endif
#ifndef REP_CONV
#define REP_CONV 1
#endif
#ifndef REP_ROW
#define REP_ROW 1
#endif
#ifndef REP_MIX
#define REP_MIX 1
#endif
constexpr int CW_Q = 8192;
#define RET_LG2(h) __builtin_amdgcn_logf(1.0f - ex2(-5.0f - (float)(h)))
#define G_EXTRA { PHASE_VARS for (int u = blockIdx.x; u < 256; u += G) { __syncthreads(); const int n = u & 31, bh = u >> 5, b = bh >> 2, h = bh & 3; const size_t r0 = (size_t)b * LP + 128 * n; \
    ret_kv_unit(lds, Z + r0 * NINP + ORK + h * 128, Z + r0 * NINP + ORV + h * 256, KVC + (size_t)(bh * 33 + n) * 32768, RET_LG2(h), 128 * n, C64, S64, tid); } \
    G_SWA }
#define H_EXTRA { PHASE_VARS const int e = blockIdx.x * (NWAVES * 64) + tid; if (e < 131072) { const int bh = e >> 14, off = (e & 16383) * 2; typedef float f32x2_t __attribute__((ext_vector_type(2))); \
    float cd = 1.0f - ex2(-5.0f - (float)(bh & 3)); _Pragma("unroll") for (int i = 0; i < 7; ++i) cd *= cd; \
    f32x2_t kvv[32]; _Pragma("unroll") for (int n = 0; n < 32; ++n) kvv[n] = *(const f32x2_t*)(KVC + (size_t)(bh * 33 + n) * 32768 + off); \
    f32x2_t st = (f32x2_t){0.f, 0.f}; \
    _Pragma("unroll") for (int n = 0; n < 33; ++n) { *(unsigned*)(PREV + (size_t)(bh * 33 + n) * 32768 + off) = pk2(st[0], st[1]); if (n < 32) st = st * cd + kvv[n]; } } }
#define MIXERS_MLA for (;;) { const int u = pop_unit(CTL + CW_Q + ((rep * DEPTH + l) * 4 + 0) * 64, MISC + 16, tid); if (u >= 528) break; const int qb = 32 - (u >> 4), b = (u >> 3) & 1, h = u & 7; const size_t r0 = (size_t)b * LP; int tid_u = tid; asm volatile("" : "+v"(tid_u)); \
    FLASH_MLA<192, 128, 0>(lds, QM + r0 * 1536 + h * 192, 1536, KM + r0 * 1536 + h * 192, 1536, KVRAW + r0 * 2048 + h * 256 + 128, 2048, OB + r0 * 1024 + h * 128, 1024, qb, 0.f, tid_u); }
#define MIXERS_MLA_PRB for (;;) { const int u = pop_unit(CTL + CW_Q + ((rep * DEPTH + l) * 4 + 0) * 64, MISC + 16, tid); if (u >= 528) break; const int qb = 32 - (u >> 4), b = (u >> 3) & 1, h = u & 7; const size_t r0 = (size_t)b * LP; int tid_u = tid; asm volatile("" : "+v"(tid_u)); \
    flash_unit2<192, 128, 0, MLA_PRB>(lds, QM + r0 * 1536 + h * 192, 1536, KM + r0 * 1536 + h * 192, 1536, KVRAW + r0 * 2048 + h * 256 + 128, 2048, (bf16*)MF + r0 * 1024 + h * 128, 1024, qb, 0.f, tid_u); }
#define MIXERS_SWA for (;;) { const int u = pop_unit(CTL + CW_Q + ((rep * DEPTH + l) * 4 + 1) * 64, MISC + 16, tid); if (u >= 528) break; const int qb = 32 - (u >> 4), b = (u >> 3) & 1, hp = u & 7, kvh = hp >> 2; const size_t r0 = (size_t)b * LP; \
    swa_gqa_unit<2>(lds, QS + r0 * 1024 + hp * 128, KS + r0 * 128 + kvh * 64, 128, Z + r0 * NINP + OSV + kvh * 64, NINP, OA + r0 * 1024 + hp * 128, qb, IN(I_SINK) + l * 16 + hp * 2, tid); }
#define MIXERS_RET for (;;) { const int u = pop_unit(CTL + CW_Q + ((rep * DEPTH + l) * 4 + 2) * 64, MISC + 16, tid); if (u >= 264) break; const int n = u % 33, bh = u / 33, b = bh >> 2, h = bh & 3; const size_t r0 = (size_t)b * LP + 128 * n; int tid_u = tid; asm volatile("" : "+v"(tid_u)); \
    ret_out_unit(lds, RQ + r0 * 512 + h * 128, RK + r0 * 512 + h * 128, Z + r0 * NINP + ORV + h * 256, PREV + (size_t)(bh * 33 + n) * 32768, Z + r0 * NINP + ORG + h * 256, IN(I_RGN) + l * 1024 + h * 256, OC + r0 * 1024 + h * 256, RET_LG2(h), tid_u); }
#ifndef MIX_SEL
#define MIX_SEL 7
#endif
#if (MIX_SEL & 1)
#define MX_A MIXERS_MLA
#else
#define MX_A mla_scalar(QM, KM, KVRAW, OB, gw, NGW, lane);
#endif
#if (MIX_SEL & 8)
#define MX_B
#define G_SWA { const int rep = 0; MIXERS_SWA }
#elif (MIX_SEL & 2)
#define G_SWA
#define MX_B MIXERS_SWA
#else
#define G_SWA
#define MX_B swa_scalar(QS, KS, Z, IN(I_SINK) + l * 16, OA, gw, NGW, lane);
#endif
#if (MIX_SEL & 4)
#define MX_C MIXERS_RET
#else
#define MX_C ret_scalar(RQ, RK, Z, IN(I_RGN) + l * 1024, OC, gw, NGW, lane);
#endif
#if REP_MIX == 4
#define MIXERS_BODY { PHASE_VARS { const int rep = 0; MX_C MX_A MX_B } } { PHASE_VARS { const int rep = 1; MIXERS_MLA_PRB } }
#elif REP_MIX == 10
#define MIXERS_BODY { PHASE_VARS { const int rep = 0; MX_C MX_A MX_B } } { PHASE_VARS { const int rep = 1; MX_A } } { PHASE_VARS { const int rep = 2; MX_A } } { PHASE_VARS { const int rep = 3; MX_A } }
#elif REP_MIX == 9
#define MIXERS_BODY { PHASE_VARS { const int rep = 0; MX_C MX_A MX_B } } { PHASE_VARS { const int rep = 1; MX_B } } { PHASE_VARS { const int rep = 2; MX_B } } { PHASE_VARS { const int rep = 3; MX_B } } { PHASE_VARS { const int rep = 4; MX_B } }
#elif REP_MIX == 2
#define MIXERS_BODY { PHASE_VARS { const int rep = 0; MX_C MX_A MX_B } } { PHASE_VARS { const int rep = 1; MX_C MX_A MX_B } }
#else
#define MIXERS_BODY { PHASE_VARS { const int rep = 0; MX_C MX_A MX_B } }
#endif
struct Args { const float* in[28]; float* out; unsigned char* ws; };
enum { I_X = 0, I_META, I_F1N, I_F1G, I_F1U, I_F1D, I_MIXN, I_WIN, I_SQN, I_SKN, I_SINK, I_QAN, I_WUQ, I_KVAN, I_WUKV, I_QNN, I_QRN, I_KNN, I_KRN, I_RGN, I_WBS, I_WBM, I_WBR, I_WO, I_F2N, I_F2G, I_F2U, I_F2D };

__global__ void __launch_bounds__(NWAVES * 64, 2) fwd(Args a) {
    extern __shared__ __attribute__((aligned(16))) unsigned char lds_raw[];
    LAS unsigned char* lds = (LAS unsigned char*)lds_raw;
    volatile LAS unsigned* MISC = (volatile LAS unsigned*)(lds + MISC_OFF);
    {
        const int tid0 = threadIdx.x;
        for (int u = tid0; u < (LDS_BYTES - LDSCTL_OFF) / 4; u += NWAVES * 64) ((LAS unsigned*)(lds + LDSCTL_OFF))[u] = 0u;
        __syncthreads();
        if (tid0 < 28) ((LAS unsigned long long*)(lds + PTAB_OFF))[tid0] = (unsigned long long)a.in[tid0];
        __syncthreads();
    }
    const int G = gridDim.x, NGW = G * NWAVES, wave0 = __builtin_amdgcn_readfirstlane((int)(threadIdx.x >> 6));
    XcdBarrier bar = xcd_barrier_post((unsigned*)(a.ws + WS_CTL) + CW_BAR, MISC + 8);
#define GRID_BAR() do { XcdBarrier b2_ = bar; unsigned long long bi_ = (unsigned long long)b2_.bar; unsigned zz_ = 0u; asm volatile("" : "+s"(bi_), "+s"(b2_.x), "+v"(zz_)); b2_.zz = zz_; b2_.bar = (unsigned*)(GAS unsigned*)bi_; xcd_barrier(b2_); } while (0)
#define PHASE_VARS unsigned z0_ = 0u; asm volatile("" : "+v"(z0_)); const int tid = wave0 * 64 + (int)__builtin_amdgcn_mbcnt_hi(~0u, __builtin_amdgcn_mbcnt_lo(~0u, z0_)); const int lane = tid & 63, wave = __builtin_amdgcn_readfirstlane(tid >> 6), gw = blockIdx.x * NWAVES + wave; \
    unsigned long long wsi_ = (unsigned long long)a.ws; asm volatile("" : "+s"(wsi_)); unsigned char* ws = (unsigned char*)(GAS unsigned char*)wsi_; (void)lane; (void)gw; \
    LAS float* const scr = (LAS float*)(lds + wave * 16384); (void)scr;
#define IN(i) in_ptr(lds, (i))
#define H ((float*)(ws + WS_H))
#define HN ((bf16*)(ws + WS_HN))
#define ACT ((bf16*)(ws + WS_ACT))
#define Z ((bf16*)(ws + WS_Z))
#define QS ((bf16*)(ws + WS_QS))
#define KS ((bf16*)(ws + WS_KS))
#define CQN ((bf16*)(ws + WS_CQN))
#define CKVN ((bf16*)(ws + WS_CKVN))
#define QRAW ((bf16*)(ws + WS_QRAW))
#define KVRAW ((bf16*)(ws + WS_KVRAW))
#define QM ((bf16*)(ws + WS_QM))
#define KM ((bf16*)(ws + WS_KM))
#define RQ ((bf16*)(ws + WS_RQ))
#define RK ((bf16*)(ws + WS_RK))
#define OA ((bf16*)(ws + WS_OA))
#define OB ((bf16*)(ws + WS_OB))
#define OC ((bf16*)(ws + WS_OC))
#define MF ((float*)(ws + WS_MF))
#define MB ((bf16*)(ws + WS_MB))
#define C64 ((float*)(ws + WS_C64))
#define S64 ((float*)(ws + WS_S64))
#define C32 ((float*)(ws + WS_C32))
#define S32 ((float*)(ws + WS_S32))
#define KVC ((float*)(ws + WS_KVC))
#define PREV ((bf16*)(ws + WS_PREV))
#define CTL ((unsigned*)(ws + WS_CTL))
#define PART ((float*)(ws + WS_PART))
#define SSQ ((float*)(ws + WS_SSQ))
#define RS ((float*)(ws + WS_RS))
#define SSQC ((float*)(ws + WS_SSQC))

    {
        PHASE_VARS
        for (int row = gw; row < M; row += NGW) { const int b = row >= LP ? 1 : 0, t = row - b * LP; float* hr = H + (size_t)row * D;
            gfp src = t >= 128 ? IN(I_X) + (size_t)(b * SEQ + t - 128) * D : IN(I_META) + (size_t)(t >= PADR ? t - PADR : 0) * D;
#pragma unroll
            for (int j = 0; j < 8; ++j) { f32x4 v = *(const GAS f32x4*)(src + 4 * lane + 256 * j); if (t < PADR) v = (f32x4){0.f, 0.f, 0.f, 0.f}; *(f32x4*)(hr + 4 * lane + 256 * j) = v; }
            fix_row(hr, HN + (size_t)row * D, RS + row, lane, nullptr, 0); }
        const int gt = blockIdx.x * (NWAVES * 64) + tid, NGT = G * NWAVES * 64;
        for (int e = gt; e < LP * 64; e += NGT) { const int t = e >> 6, i = e & 63; const double ang = (double)(t - PADR) * exp2(-(double)i * (13.287712379549449 / 64.0));
            const double k = rint(ang * 0.15915494309189535); const float r = (float)(ang - k * 6.283185307179586); C64[e] = cosf(r); S64[e] = sinf(r); }
        for (int e = gt; e < LP * 32; e += NGT) { const int t = e >> 5, i = e & 31; const double ang = (double)(t - PADR) * exp2(-(double)i * (13.287712379549449 / 32.0));
            const double k = rint(ang * 0.15915494309189535); const float r = (float)(ang - k * 6.283185307179586); C32[e] = cosf(r); S32[e] = sinf(r); }
        v4u* zp = (v4u*)(ws + W_IN + (size_t)NIN * D * 2);
        for (int e = gt; e < (NINP - NIN) * D * 2 / 16; e += NGT) zp[e] = (v4u){0u, 0u, 0u, 0u};
    }
    GRID_BAR();

    for (int l = 0; l < DEPTH; ++l) {
        {
            PHASE_VARS
            constexpr int I_FFN = (D / 64) * (FF / 32), I_DN = (FF / 64) * (D / 32), I_IN = (D / 64) * (NIN / 32), I_UQ = (512 / 64) * (1536 / 32), I_UKV = (512 / 64) * (2048 / 32), I_BR = (1024 / 64) * (D / 32), I_O = (D / 64) * (D / 32);
            constexpr int NITEMS = 4 * I_FFN + 2 * I_DN + I_IN + I_UQ + I_UKV + 3 * I_BR + I_O;
            for (int rep = 0; rep < REP_CONV; ++rep)
            for (int it = gw; it < NITEMS; it += NGW) {
                int r = it;
                if (r < I_FFN) { cvt_gu(IN(I_F1G) + (size_t)l * D * FF, (bf16*)(ws + W_GU1), 0, r, scr, lane, IN(I_F1N) + l * D); continue; } r -= I_FFN;
                if (r < I_FFN) { cvt_gu(IN(I_F1U) + (size_t)l * D * FF, (bf16*)(ws + W_GU1), 1, r, scr, lane, IN(I_F1N) + l * D); continue; } r -= I_FFN;
                if (r < I_FFN) { cvt_gu(IN(I_F2G) + (size_t)l * D * FF, (bf16*)(ws + W_GU2), 0, r, scr, lane, IN(I_F2N) + l * D); continue; } r -= I_FFN;
                if (r < I_FFN) { cvt_gu(IN(I_F2U) + (size_t)l * D * FF, (bf16*)(ws + W_GU2), 1, r, scr, lane, IN(I_F2N) + l * D); continue; } r -= I_FFN;
                if (r < I_DN) { cvt_plain(IN(I_F1D) + (size_t)l * D * FF, FF, D, (bf16*)(ws + W_D1), r, scr, lane, (gfp)nullptr); continue; } r -= I_DN;
                if (r < I_DN) { cvt_plain(IN(I_F2D) + (size_t)l * D * FF, FF, D, (bf16*)(ws + W_D2), r, scr, lane, (gfp)nullptr); continue; } r -= I_DN;
                if (r < I_IN) { cvt_plain(IN(I_WIN) + (size_t)l * D * NIN, D, NIN, (bf16*)(ws + W_IN), r, scr, lane, IN(I_MIXN) + l * D); continue; } r -= I_IN;
                if (r < I_UQ) { cvt_plain(IN(I_WUQ) + (size_t)l * 512 * 1536, 512, 1536, (bf16*)(ws + W_UQ), r, scr, lane, IN(I_QAN) + l * 512); continue; } r -= I_UQ;
                if (r < I_UKV) { cvt_plain(IN(I_WUKV) + (size_t)l * 512 * 2048, 512, 2048, (bf16*)(ws + W_UKV), r, scr, lane, IN(I_KVAN) + l * 512); continue; } r -= I_UKV;
                if (r < I_BR) { cvt_plain(IN(I_WBS) + (size_t)l * 1024 * D, 1024, D, (bf16*)(ws + W_BS), r, scr, lane, (gfp)nullptr); continue; } r -= I_BR;
                if (r < I_BR) { cvt_plain(IN(I_WBM) + (size_t)l * 1024 * D, 1024, D, (bf16*)(ws + W_BM), r, scr, lane, (gfp)nullptr); continue; } r -= I_BR;
                if (r < I_BR) { cvt_plain(IN(I_WBR) + (size_t)l * 1024 * D, 1024, D, (bf16*)(ws + W_BR), r, scr, lane, (gfp)nullptr); continue; } r -= I_BR;
                cvt_plain(IN(I_WO) + (size_t)l * D * D, D, D, (bf16*)(ws + W_O), r, scr, lane, (gfp)nullptr);
            }
            if (l > 0) { fix_panel32<22>(H, HN, RS + (size_t)(l * 3) * M + 8192, PART, (volatile LAS float*)(MISC + 32), tid, lane, wave);
                row_scales(SSQ + (size_t)(l * 3) * M * 32, RS + (size_t)(l * 3) * M, blockIdx.x * (NWAVES * 64) + tid, G * NWAVES * 64); }
        }
        GRID_BAR();
        { PHASE_VARS pg8::Gemm g{HN, (const bf16*)(ws + W_GU1), M, NGU, D, D}; pg8::StaticOrder S; S.init(g, G, (int)blockIdx.x); pg8::EpiSwiglu E{ACT, FF, RS + (size_t)(l * 3) * M};
          pg8::gemm_phase<pg8::EpiSwiglu, pg8::StaticOrder, true, true>(lds, g, S, E, tid); }
#if REP_GU == 2
        GRID_BAR();
        { PHASE_VARS pg8::Gemm g{HN, (const bf16*)(ws + W_GU1), M, NGU, D, D}; pg8::StaticOrder S; S.init(g, G, (int)blockIdx.x); pg8::EpiSwiglu E{ACT, FF, RS + (size_t)(l * 3) * M};
          pg8::gemm_phase<pg8::EpiSwiglu, pg8::StaticOrder, true, true>(lds, g, S, E, tid); }
#elif REP_GU == 3
        GRID_BAR();
        { PHASE_VARS pg8::Gemm g{HN, (const bf16*)(ws + W_GU1), M, NGU, D, D}; pg8::StaticOrder S; S.init(g, G, (int)blockIdx.x); pg8::EpiNull E{};
          pg8::gemm_phase<pg8::EpiNull, pg8::StaticOrder, true, true>(lds, g, S, E, tid); }
#elif REP_GU == 4
        GRID_BAR();
        { PHASE_VARS pg8::Gemm g{HN, (const bf16*)(ws + W_GU1), M, NGU, D, D}; pg8::SameTileOrder S; S.init(g, G, (int)blockIdx.x); pg8::EpiNull E{};
          pg8::gemm_phase<pg8::EpiNull, pg8::SameTileOrder, true, true>(lds, g, S, E, tid); }
#endif
        GRID_BAR();
#if REP_REST == 2
        { PHASE_VARS pg8::Gemm g{ACT, (const bf16*)(ws + W_D1), M, D, FF, FF}; pg8::TailOrder S; S.init(g, 22, (int)blockIdx.x); pg8::EpiResidT<0> E{H, PART, 0ull, HN, (float*)nullptr};
          pg8::gemm_phase<decltype(E), pg8::TailOrder, true, true>(lds, g, S, E, tid); }
        GRID_BAR();
#endif
        { PHASE_VARS pg8::Gemm g{ACT, (const bf16*)(ws + W_D1), M, D, FF, FF}; pg8::TailOrder S; S.init(g, 22, (int)blockIdx.x); pg8::EpiResidT<1> E{H, PART, 0ull, HN, SSQ + (size_t)(l * 3 + 1) * M * 32};
          pg8::gemm_phase<decltype(E), pg8::TailOrder, true, true>(lds, g, S, E, tid); }
        GRID_BAR();
        { PHASE_VARS fix_panel32<22>(H, HN, RS + (size_t)(l * 3 + 1) * M + 8192, PART, (volatile LAS float*)(MISC + 32), tid, lane, wave);
          row_scales(SSQ + (size_t)(l * 3 + 1) * M * 32, RS + (size_t)(l * 3 + 1) * M, blockIdx.x * (NWAVES * 64) + tid, G * NWAVES * 64); }
        GRID_BAR();
#if REP_REST == 2
        { PHASE_VARS pg8::Gemm g{HN, (const bf16*)(ws + W_IN), M, NINP, D, D}; pg8::StaticOrder S; S.init(g, G, (int)blockIdx.x); pg8::EpiZ E{Z, NINP, RS + (size_t)(l * 3 + 1) * M, SSQC};
          pg8::gemm_phase<pg8::EpiZ, pg8::StaticOrder, true, true>(lds, g, S, E, tid); }
        GRID_BAR();
#endif
        { PHASE_VARS pg8::Gemm g{HN, (const bf16*)(ws + W_IN), M, NINP, D, D}; pg8::StaticOrder S; S.init(g, G, (int)blockIdx.x); pg8::EpiZ E{Z, NINP, RS + (size_t)(l * 3 + 1) * M, SSQC};
          pg8::gemm_phase<pg8::EpiZ, pg8::StaticOrder, true, true>(lds, g, S, E, tid); }
        GRID_BAR();
        { PHASE_VARS pg8::Gemm g{Z + OCQ, (const bf16*)(ws + W_UQ), M, 3584, 512, NINP}; pg8::DualOrder S; S.init(g, G, (int)blockIdx.x); S.A2 = (const char*)(Z + OCKV); S.B1 = (const char*)(ws + W_UQ); S.B2 = (const char*)(ws + W_UKV);
          pg8::EpiQKV E{QRAW, KVRAW, SSQC};
          pg8::gemm_phase<pg8::EpiQKV, pg8::DualOrder, true, true>(lds, g, S, E, tid); }
        G_EXTRA
        GRID_BAR();
        { PHASE_VARS
        for (int rep = 0; rep < REP_ROW; ++rep)
        for (int row = gw; row < M; row += NGW) {
            const int b = row >= LP ? 1 : 0, t = row - b * LP; const bf16* zr = Z + (size_t)row * NINP;
            const int h = lane >> 3, part = lane & 7, ll = lane & 15, i32 = lane & 31, h4 = lane >> 4, i0r = 4 * (lane & 15), i0q = 4 * part;
            const v4u Lq0 = *(const v4u*)(zr + OQ + 16 * lane), Lq1 = *(const v4u*)(zr + OQ + 16 * lane + 8);
            const v4u Lk = *(const v4u*)(zr + OSK + 8 * ll);
            const bf16 Lr1 = zr[OKR + i32], Lr2 = zr[OKR + 32 + i32];
            const v2u Lrq1 = *(const v2u*)(zr + ORQ + h4 * 128 + i0r), Lrq2 = *(const v2u*)(zr + ORQ + h4 * 128 + i0r + 64);
            const v2u Lrk1 = *(const v2u*)(zr + ORK + h4 * 128 + i0r), Lrk2 = *(const v2u*)(zr + ORK + h4 * 128 + i0r + 64);
            const f32x4 Lc64 = *(const f32x4*)(C64 + t * 64 + i0r), Ls64 = *(const f32x4*)(S64 + t * 64 + i0r);
            const float Lc32 = C32[t * 32 + i32], Ls32 = S32[t * 32 + i32];
            const bf16* pq = QRAW + (size_t)row * 1536 + h * 192;
            const v4u Lqn0 = *(const v4u*)(pq + 16 * part), Lqn1 = *(const v4u*)(pq + 16 * part + 8);
            const v2u Lqr1 = *(const v2u*)(pq + 128 + i0q), Lqr2 = *(const v2u*)(pq + 160 + i0q);
            const f32x4 Lc32v = *(const f32x4*)(C32 + t * 32 + i0q), Ls32v = *(const f32x4*)(S32 + t * 32 + i0q);
            const bf16* pk = KVRAW + (size_t)row * 2048 + h * 256 + 16 * part;
            const v4u Lkn0 = *(const v4u*)pk, Lkn1 = *(const v4u*)(pk + 8);
            f32x4 Gq[4], Gk[2], Gqn[4], Gkn[4];
            { gfp g = IN(I_SQN) + l * 64 + ((16 * lane) & 63);
#pragma unroll
              for (int i = 0; i < 4; ++i) Gq[i] = *(const GAS f32x4*)(g + 4 * i); }
            { gfp g = IN(I_SKN) + l * 64 + ((8 * ll) & 63); Gk[0] = *(const GAS f32x4*)g; Gk[1] = *(const GAS f32x4*)(g + 4); }
            const float Gr1 = IN(I_KRN)[l * 64 + i32], Gr2 = IN(I_KRN)[l * 64 + 32 + i32];
            { gfp g = IN(I_QNN) + l * 128 + 16 * part;
#pragma unroll
              for (int i = 0; i < 4; ++i) Gqn[i] = *(const GAS f32x4*)(g + 4 * i); }
            const f32x4 Gqr1 = *(const GAS f32x4*)(IN(I_QRN) + l * 64 + i0q), Gqr2 = *(const GAS f32x4*)(IN(I_QRN) + l * 64 + 32 + i0q);
            { gfp g = IN(I_KNN) + l * 128 + 16 * part;
#pragma unroll
              for (int i = 0; i < 4; ++i) Gkn[i] = *(const GAS f32x4*)(g + 4 * i); }
            {
                float f[16]; unpack8(Lq0, f); unpack8(Lq1, f + 8);
                float ss = 0.f;
#pragma unroll
                for (int i = 0; i < 16; ++i) ss += f[i] * f[i];
                const float r = rsqrtf(grp_sum<4>(ss, lane) * (1.0f / 64.0f) + EPS) * SWA_QS;
#pragma unroll
                for (int i = 0; i < 16; ++i) f[i] *= r * Gq[i >> 2][i & 3];
                *(v4u*)(QS + (size_t)row * 1024 + 16 * lane) = pack8(f); *(v4u*)(QS + (size_t)row * 1024 + 16 * lane + 8) = pack8(f + 8);
            }
            {
                float f[8]; unpack8(Lk, f);
                float ss = 0.f;
#pragma unroll
                for (int i = 0; i < 8; ++i) ss += f[i] * f[i];
                const float r = rsqrtf(grp_sum<8>(ss, lane) * (1.0f / 64.0f) + EPS);
#pragma unroll
                for (int i = 0; i < 8; ++i) f[i] *= r * Gk[i >> 2][i & 3];
                if (lane < 16) *(v4u*)(KS + (size_t)row * 128 + 8 * ll) = pack8(f);
            }
            {
                const float x1 = bf2f(Lr1), x2 = bf2f(Lr2);
                const float ss = wave_sum(lane < 32 ? x1 * x1 + x2 * x2 : 0.f, lane); const float r = rsqrtf(ss * (1.0f / 64.0f) + EPS);
                const float y1 = x1 * r * Gr1, y2 = x2 * r * Gr2;
                const bf16 o1 = (bf16)f2bf(y1 * Lc32 - y2 * Ls32), o2 = (bf16)f2bf(y2 * Lc32 + y1 * Ls32);
                if (lane < 32) {
#pragma unroll
                    for (int hh = 0; hh < 8; ++hh) { KM[(size_t)row * 1536 + hh * 192 + 128 + i32] = o1; KM[(size_t)row * 1536 + hh * 192 + 160 + i32] = o2; } }
            }
#pragma unroll
            for (int which = 0; which < 2; ++which) {
                const v2u w1 = which ? Lrk1 : Lrq1, w2 = which ? Lrk2 : Lrq2;
                const float x1[4] = {blo(w1.x), bhi(w1.x), blo(w1.y), bhi(w1.y)}, x2[4] = {blo(w2.x), bhi(w2.x), blo(w2.y), bhi(w2.y)};
                const float sc = which ? (t >= PADR ? RET_KS : 0.f) : 1.f;
                float o1[4], o2[4];
#pragma unroll
                for (int j = 0; j < 4; ++j) { o1[j] = (x1[j] * Lc64[j] - x2[j] * Ls64[j]) * sc; o2[j] = (x2[j] * Lc64[j] + x1[j] * Ls64[j]) * sc; }
                bf16* q = (which ? RK : RQ) + (size_t)row * 512 + h4 * 128 + i0r;
                v2u u1, u2; u1.x = pk2(o1[0], o1[1]); u1.y = pk2(o1[2], o1[3]); u2.x = pk2(o2[0], o2[1]); u2.y = pk2(o2[2], o2[3]);
                *(v2u*)q = u1; *(v2u*)(q + 64) = u2;
            }
            {
                float f[16]; unpack8(Lqn0, f); unpack8(Lqn1, f + 8);
                float ss = 0.f;
#pragma unroll
                for (int i = 0; i < 16; ++i) ss += f[i] * f[i];
                const float r = rsqrtf(grp_sum<8>(ss, lane) * (1.0f / 128.0f) + EPS) * MLA_QS;
#pragma unroll
                for (int i = 0; i < 16; ++i) f[i] *= r * Gqn[i >> 2][i & 3];
                bf16* q = QM + (size_t)row * 1536 + h * 192 + 16 * part; *(v4u*)q = pack8(f); *(v4u*)(q + 8) = pack8(f + 8);
            }
            {
                float x1[4] = {blo(Lqr1.x), bhi(Lqr1.x), blo(Lqr1.y), bhi(Lqr1.y)}, x2[4] = {blo(Lqr2.x), bhi(Lqr2.x), blo(Lqr2.y), bhi(Lqr2.y)};
                float ss = 0.f;
#pragma unroll
                for (int j = 0; j < 4; ++j) ss += x1[j] * x1[j] + x2[j] * x2[j];
                const float r = rsqrtf(grp_sum<8>(ss, lane) * (1.0f / 64.0f) + EPS);
                float o1[4], o2[4];
#pragma unroll
                for (int j = 0; j < 4; ++j) { const float y1 = x1[j] * r * Gqr1[j], y2 = x2[j] * r * Gqr2[j]; o1[j] = (y1 * Lc32v[j] - y2 * Ls32v[j]) * MLA_QS; o2[j] = (y2 * Lc32v[j] + y1 * Ls32v[j]) * MLA_QS; }
                bf16* q = QM + (size_t)row * 1536 + h * 192 + 128 + i0q;
                v2u u1, u2; u1.x = pk2(o1[0], o1[1]); u1.y = pk2(o1[2], o1[3]); u2.x = pk2(o2[0], o2[1]); u2.y = pk2(o2[2], o2[3]);
                *(v2u*)q = u1; *(v2u*)(q + 32) = u2;
            }
            {
                float f[16]; unpack8(Lkn0, f); unpack8(Lkn1, f + 8);
                float ss = 0.f;
#pragma unroll
                for (int i = 0; i < 16; ++i) ss += f[i] * f[i];
                const float r = rsqrtf(grp_sum<8>(ss, lane) * (1.0f / 128.0f) + EPS);
#pragma unroll
                for (int i = 0; i < 16; ++i) f[i] *= r * Gkn[i >> 2][i & 3];
                bf16* q = KM + (size_t)row * 1536 + h * 192 + 16 * part; *(v4u*)q = pack8(f); *(v4u*)(q + 8) = pack8(f + 8);
            }
        } }
        H_EXTRA
        GRID_BAR();
        MIXERS_BODY
        GRID_BAR();
#if REP_REST == 2
        { PHASE_VARS pg8::Gemm g{OA, (const bf16*)(ws + W_BS), M, D, 1024, 1024};
          static_assert(WS_OB - WS_OA == WS_OC - WS_OB && W_BM - W_BS == W_BR - W_BM, "equally spaced branch buffers");
          pg8::BranchOrder S{(int)blockIdx.x, (const char*)OA, (const char*)(ws + W_BS), WS_OB - WS_OA, W_BM - W_BS};
          pg8::EpiGateR E{Z + OG, NINP, MB, PART};
          pg8::gemm_phase<pg8::EpiGateR, pg8::BranchOrder, true, true>(lds, g, S, E, tid); }
        GRID_BAR();
#endif
        { PHASE_VARS pg8::Gemm g{OA, (const bf16*)(ws + W_BS), M, D, 1024, 1024};
          static_assert(WS_OB - WS_OA == WS_OC - WS_OB && W_BM - W_BS == W_BR - W_BM, "equally spaced branch buffers");
          pg8::BranchOrder S{(int)blockIdx.x, (const char*)OA, (const char*)(ws + W_BS), WS_OB - WS_OA, W_BM - W_BS};
          pg8::EpiGateR E{Z + OG, NINP, MB, PART};
          pg8::gemm_phase<pg8::EpiGateR, pg8::BranchOrder, true, true>(lds, g, S, E, tid); }
        GRID_BAR();
        { PHASE_VARS for (int lrow = blockIdx.x; lrow < 256; lrow += G) { const int col = 256 * wave + 4 * lane; f32x4 pp[12];
#pragma unroll
            for (int sidx = 0; sidx < 12; ++sidx) pp[sidx] = *(const f32x4*)(PART + ((size_t)sidx * 256 + lrow) * 2048 + col);
            f32x4 v = pp[0];
#pragma unroll
            for (int sidx = 1; sidx < 12; ++sidx) v = v + pp[sidx];
            v2u w; w.x = pk2(v.x, v.y); w.y = pk2(v.z, v.w); *(v2u*)(MB + (size_t)(8192 + lrow) * 2048 + col) = w; } }
        GRID_BAR();
#if REP_REST == 2
        { PHASE_VARS pg8::Gemm g{MB, (const bf16*)(ws + W_O), M, D, D, D}; pg8::TailOrder S; S.init(g, 8, (int)blockIdx.x); pg8::EpiResidT<0> E{H, PART, 0ull, HN, (float*)nullptr};
          pg8::gemm_phase<decltype(E), pg8::TailOrder, true, true>(lds, g, S, E, tid); }
        GRID_BAR();
#endif
        { PHASE_VARS pg8::Gemm g{MB, (const bf16*)(ws + W_O), M, D, D, D}; pg8::TailOrder S; S.init(g, 8, (int)blockIdx.x); pg8::EpiResidT<2> E{H, PART, 0ull, HN, SSQ + (size_t)(l * 3 + 2) * M * 32};
          pg8::gemm_phase<decltype(E), pg8::TailOrder, true, true>(lds, g, S, E, tid); }
        GRID_BAR();
        { PHASE_VARS fix_panel32<8>(H, HN, RS + (size_t)(l * 3 + 2) * M + 8192, PART, (volatile LAS float*)(MISC + 32), tid, lane, wave);
          row_scales(SSQ + (size_t)(l * 3 + 2) * M * 32, RS + (size_t)(l * 3 + 2) * M, blockIdx.x * (NWAVES * 64) + tid, G * NWAVES * 64); }
        GRID_BAR();
        { PHASE_VARS pg8::Gemm g{HN, (const bf16*)(ws + W_GU2), M, NGU, D, D}; pg8::StaticOrder S; S.init(g, G, (int)blockIdx.x); pg8::EpiSwiglu E{ACT, FF, RS + (size_t)(l * 3 + 2) * M};
          pg8::gemm_phase<pg8::EpiSwiglu, pg8::StaticOrder, true, true>(lds, g, S, E, tid); }
#if REP_GU == 2
        GRID_BAR();
        { PHASE_VARS pg8::Gemm g{HN, (const bf16*)(ws + W_GU2), M, NGU, D, D}; pg8::StaticOrder S; S.init(g, G, (int)blockIdx.x); pg8::EpiSwiglu E{ACT, FF, RS + (size_t)(l * 3 + 2) * M};
          pg8::gemm_phase<pg8::EpiSwiglu, pg8::StaticOrder, true, true>(lds, g, S, E, tid); }
#elif REP_GU == 3
        GRID_BAR();
        { PHASE_VARS pg8::Gemm g{HN, (const bf16*)(ws + W_GU2), M, NGU, D, D}; pg8::StaticOrder S; S.init(g, G, (int)blockIdx.x); pg8::EpiNull E{};
          pg8::gemm_phase<pg8::EpiNull, pg8::StaticOrder, true, true>(lds, g, S, E, tid); }
#elif REP_GU == 4
        GRID_BAR();
        { PHASE_VARS pg8::Gemm g{HN, (const bf16*)(ws + W_GU2), M, NGU, D, D}; pg8::SameTileOrder S; S.init(g, G, (int)blockIdx.x); pg8::EpiNull E{};
          pg8::gemm_phase<pg8::EpiNull, pg8::SameTileOrder, true, true>(lds, g, S, E, tid); }
#endif
        GRID_BAR();
#if REP_REST == 2
        { PHASE_VARS pg8::Gemm g{ACT, (const bf16*)(ws + W_D2), M, D, FF, FF}; pg8::TailOrder S; S.init(g, 22, (int)blockIdx.x); pg8::EpiResidT<0> E{H, PART, 0ull, HN, (float*)nullptr};
          pg8::gemm_phase<decltype(E), pg8::TailOrder, true, true>(lds, g, S, E, tid); }
        GRID_BAR();
#endif
        { PHASE_VARS pg8::Gemm g{ACT, (const bf16*)(ws + W_D2), M, D, FF, FF}; pg8::TailOrder S; S.init(g, 22, (int)blockIdx.x); pg8::EpiResidT<1> E{H, PART, l == DEPTH - 1 ? (unsigned long long)a.out : 0ull, HN, l == DEPTH - 1 ? (float*)nullptr : SSQ + (size_t)((l + 1) * 3) * M * 32};
          pg8::gemm_phase<decltype(E), pg8::TailOrder, true, true>(lds, g, S, E, tid); }
        GRID_BAR();
    }
    { PHASE_VARS for (int lrow = gw; lrow < 256; lrow += NGW) { const int row = 8192 + lrow;
#pragma unroll
        for (int jj = 0; jj < 8; ++jj) { f32x4 v = *(const f32x4*)(H + (size_t)row * D + 4 * lane + 256 * jj);
            for (int sidx = 0; sidx < 22; ++sidx) v = v + *(const f32x4*)(PART + ((size_t)sidx * 256 + lrow) * 2048 + 4 * lane + 256 * jj);
            *(f32x4*)(a.out + (size_t)(row - 256) * D + 4 * lane + 256 * jj) = v; } } }
}
extern "C" void kernel_launch(void* const* d_in, const int* in_sizes, int n_in, void* d_out, int out_size, void* d_ws, size_t ws_size, hipStream_t stream) {
    static int grid = 0;
    if (grid == 0) {
        if (n_in != 28 || in_sizes[0] != NB * SEQ * D || out_size != NB * SEQ * D || ws_size < WS_END) {
            fprintf(stderr, "kernel_launch: unexpected shapes: n_in %d, in0 %d, out %d, ws %zu (need %zu); nothing launched\n", n_in, n_in > 0 ? in_sizes[0] : -1, out_size, ws_size, (size_t)WS_END); grid = -1; return; }
        int dev = 0, cus = 0, per_cu = 0;
        if (hipGetDevice(&dev) != hipSuccess || hipDeviceGetAttribute(&cus, hipDeviceAttributeMultiprocessorCount, dev) != hipSuccess) { fprintf(stderr, "kernel_launch: device query failed\n"); grid = -1; return; }
        if (hipFuncSetAttribute((const void*)fwd, hipFuncAttributeMaxDynamicSharedMemorySize, LDS_BYTES) != hipSuccess) { fprintf(stderr, "kernel_launch: hipFuncSetAttribute failed\n"); grid = -1; return; }
        if (hipOccupancyMaxActiveBlocksPerMultiprocessor(&per_cu, (const void*)fwd, NWAVES * 64, LDS_BYTES) != hipSuccess || per_cu < 1) {
            fprintf(stderr, "kernel_launch: occupancy query reports %d workgroups per CU; nothing launched\n", per_cu); (void)hipGetLastError(); grid = -1; return; }
        (void)hipGetLastError();
        if (cus != 256) { fprintf(stderr, "kernel_launch: built for a 256-CU device (the unit orders of the N = 2048 GEMMs assume 256 workgroups); found %d; nothing launched\n", cus); grid = -1; return; }
        grid = cus;
    }
    if (grid < 0) return;
    if (hipMemsetAsync((char*)d_ws + WS_CTL, 0, CTL_ZERO_BYTES, stream) != hipSuccess) { fprintf(stderr, "kernel_launch: memset failed\n"); return; }
    Args a{};
    for (int i = 0; i < 28; ++i) a.in[i] = (const float*)d_in[i];
    a.out = (float*)d_out; a.ws = (unsigned char*)d_ws;
    hipLaunchKernelGGL(fwd, dim3(grid), dim3(NWAVES * 64), LDS_BYTES, stream, a);
    const hipError_t le = hipPeekAtLastError();
    if (le != hipSuccess) fprintf(stderr, "kernel_launch: launch failed: %s\n", hipGetErrorName(le));
}
```

```cpp
#include <hip/hip_runtime.h>
#include <cstdio>
#include <cstdint>
#include <cmath>
namespace pg8 {
#define PG8_LAS __attribute__((address_space(3)))
typedef unsigned short bf16_t;
typedef short bf16x8 __attribute__((ext_vector_type(8)));
typedef float f32x4 __attribute__((ext_vector_type(4)));
typedef unsigned u32x4 __attribute__((ext_vector_type(4)));
constexpr int BM = 256, BK = 64, HALF = 128, HTB = HALF * BK * 2  , STAGE_BYTES = 8 * HTB, NXCD = 8, WGM = 8;

__host__ __device__ __forceinline__ int lds_byte(int r, int c) { const int st = (r >> 4) * 2 + (c >> 5), rr = r & 15, cc = c & 31, ob = rr * 64 + cc * 2; return st * 1024 + (ob ^ (((ob >> 9) & 1) << 5)); }
__host__ __device__ __forceinline__ void stage_rc(int b, int& R, int& C) { const int st = b / 1024, sb = b % 1024, swz = sb ^ (((sb >> 9) & 1) << 5); R = (st >> 1) * 16 + swz / 64; C = (st & 1) * 32 + (swz % 64) / 2; }
__host__ __device__ __forceinline__ int perm32(int rho) { const int n = rho >> 4, i = rho & 15; return 8 * (i >> 2) + 4 * n + (i & 3); }

struct Unit { int pm, pn, nk, tag; const char* a; const char* b; };
struct Gemm { const bf16_t* A; const bf16_t* Bt; int M, N, K, lda; };

struct StaticOrder {
    int nM, nN, nwg, G, c, K, lda; const char* A; const char* Bt;
    __host__ __device__ void init(const Gemm& g, int G_, int c_) { nM = g.M / BM; nN = g.N / BM; nwg = nM * nN; G = G_; c = c_; K = g.K; lda = g.lda; A = (const char*)g.A; Bt = (const char*)g.Bt; }
    __host__ __device__ bool next(int i, Unit& u) const {
        const long L = (long)i * G + c; if (L >= nwg) return false;
        int wgid = (int)L; { const int q = nwg / NXCD, r = nwg % NXCD, xcd = wgid % NXCD, off = wgid / NXCD; wgid = (xcd < r ? xcd * (q + 1) : r * (q + 1) + (xcd - r) * q) + off; }
        const int nig = WGM * nN, gid = wgid / nig, fm = gid * WGM, gsz = (nM - fm) < WGM ? (nM - fm) : WGM;
        u.pm = fm + ((wgid % nig) % gsz); u.pn = (wgid % nig) / gsz; u.nk = K / BK; u.tag = 0; u.a = A + (size_t)u.pm * ((size_t)BM * lda * 2); u.b = Bt + (size_t)u.pn * ((size_t)BM * K * 2); return true;
    }
    __device__ __forceinline__ void a_ready(const Unit&) const {}
    __device__ __forceinline__ void done(const Unit&) const {}
};

__device__ __forceinline__ unsigned cvt_pk_bf16(float lo, float hi) { unsigned r; asm volatile("v_cvt_pk_bf16_f32 %0, %1, %2" : "=v"(r) : "v"(lo), "v"(hi)); return r; }
typedef float f32x2 __attribute__((ext_vector_type(2)));
__device__ __forceinline__ f32x2 gelu_pk(f32x2 v) {
    const f32x2 av = __builtin_elementwise_abs(v), d = av * 0.2316418882f + 1.0f;
    f32x2 t; t.x = __builtin_amdgcn_rcpf(d.x); t.y = __builtin_amdgcn_rcpf(d.y);
    f32x2 q = t * 0.5307027145f + (-0.7265760135f); q = q * t + 0.7107068705f; q = q * t + (-0.142248368f); q = q * t + 0.127414796f; q = q * t;
    const f32x2 s = (v * v) * (-0.72134752044f);
    f32x2 e; e.x = __builtin_amdgcn_exp2f(s.x); e.y = __builtin_amdgcn_exp2f(s.y);
    const f32x2 m = v * (q * e), r = v - m;
    f32x2 o; o.x = v.x < 0.f ? m.x : r.x; o.y = v.y < 0.f ? m.y : r.y; return o;
}

template <int ACT  > struct EpiBf16 {
    static constexpr bool PERM = true, AFTER_DRAIN = false; static_assert(ACT == 0 || ACT == 1, "EpiBf16: ACT is 0 (none) or 1 (gelu_pk)");
    bf16_t* O; int ldc; const float* bias; int split_cols; size_t split_stride; float scale0;
    __device__ __forceinline__ void operator()(const f32x4 (&acc)[2][2][4][2], const Unit& u, int wr, int wc, int fr, int fq) const {
        const int row0 = u.pm * BM + wr * 64 + fr; int colt = u.pn * BM; bf16_t* base = O;
        float sc = 1.f; if (split_cols) { const int t = colt / split_cols; base += (size_t)t * split_stride; colt -= t * split_cols; if (t == 0) sc = scale0; }
        const int col0 = colt + wc * 32 + 8 * fq, bcol0 = u.pn * BM + wc * 32 + 8 * fq;
        f32x4 bv[2][2];
#pragma unroll
        for (int bj = 0; bj < 2; ++bj)
#pragma unroll
            for (int n = 0; n < 2; ++n) bv[bj][n] = bias ? *(const f32x4*)(bias + bcol0 + bj * HALF + 4 * n) : (f32x4){0.f, 0.f, 0.f, 0.f};
#pragma unroll
        for (int ai = 0; ai < 2; ++ai)
#pragma unroll
            for (int m = 0; m < 4; ++m) { bf16_t* rowp = base + (size_t)(row0 + ai * HALF + m * 16) * ldc + col0;
#pragma unroll
                for (int bj = 0; bj < 2; ++bj) { f32x4 v0 = acc[ai][bj][m][0] + bv[bj][0], v1 = acc[ai][bj][m][1] + bv[bj][1];
                    if (ACT == 1) { f32x2 a = gelu_pk((f32x2){v0[0], v0[1]}), b = gelu_pk((f32x2){v0[2], v0[3]}), c = gelu_pk((f32x2){v1[0], v1[1]}), d = gelu_pk((f32x2){v1[2], v1[3]});
                        v0 = (f32x4){a.x, a.y, b.x, b.y}; v1 = (f32x4){c.x, c.y, d.x, d.y}; }
                    v0 = v0 * sc; v1 = v1 * sc; u32x4 w; w.x = cvt_pk_bf16(v0[0], v0[1]); w.y = cvt_pk_bf16(v0[2], v0[3]); w.z = cvt_pk_bf16(v1[0], v1[1]); w.w = cvt_pk_bf16(v1[2], v1[3]);
                    *(u32x4*)(rowp + bj * HALF) = w; } }
    }
};
__device__ __forceinline__ float silu_f(float x) { return x * __builtin_amdgcn_rcpf(1.0f + __expf(-x)); }
__device__ __forceinline__ float sigmoid_f(float x) { return __builtin_amdgcn_rcpf(1.0f + __expf(-x)); }
__device__ __forceinline__ float bf_lo(unsigned w) { return __uint_as_float(w << 16); }
__device__ __forceinline__ float bf_hi(unsigned w) { return __uint_as_float(w & 0xffff0000u); }
__device__ __forceinline__ float row_scale(const float* SSQ, int row) {
    const f32x4* q = (const f32x4*)(SSQ + (size_t)row * 32); f32x4 a = q[0];
#pragma unroll
    for (int i = 1; i < 8; ++i) a = a + q[i];
    return __builtin_amdgcn_rsqf(((a[0] + a[1]) + (a[2] + a[3])) * (1.0f / 2048.0f) + 1e-6f);
}
struct EpiSwiglu {
    static constexpr bool PERM = true, AFTER_DRAIN = false;
    bf16_t* O; int ldc; const float* SSQ;
    static constexpr bool ROWSC = true;
    __device__ __forceinline__ void operator()(const f32x4 (&acc)[2][2][4][2], const Unit& u, int wr, int wc, int fr, int fq, const PG8_LAS float* rsl) const {
        asm volatile("" : "+v"(fr), "+v"(fq));
        const int row0 = u.pm * BM + wr * 64 + fr, col0 = u.pn * HALF + wc * 32 + 8 * fq;
        float rr[2][4];
#pragma unroll
        for (int ai = 0; ai < 2; ++ai)
#pragma unroll
            for (int m = 0; m < 4; ++m) rr[ai][m] = rsl[wr * 64 + fr + ai * HALF + m * 16];
        asm volatile("" : "+v"(rr[0][0]), "+v"(rr[0][1]), "+v"(rr[0][2]), "+v"(rr[0][3]), "+v"(rr[1][0]), "+v"(rr[1][1]), "+v"(rr[1][2]), "+v"(rr[1][3]));
#pragma unroll
        for (int ai = 0; ai < 2; ++ai)
#pragma unroll
            for (int m = 0; m < 4; ++m) { const int row = row0 + ai * HALF + m * 16; bf16_t* p = O + (size_t)row * ldc + col0;
                const float r = rr[ai][m], rl = r * -1.44269504088896f, r2 = r * r;
                u32x4 w;
#pragma unroll
                for (int n = 0; n < 2; ++n)
#pragma unroll
                    for (int hf = 0; hf < 2; ++hf) { const f32x2 g = {acc[ai][0][m][n][2 * hf], acc[ai][0][m][n][2 * hf + 1]}, uu = {acc[ai][1][m][n][2 * hf], acc[ai][1][m][n][2 * hf + 1]};
                        const f32x2 a = g * rl; f32x2 e; e.x = __builtin_amdgcn_exp2f(a.x); e.y = __builtin_amdgcn_exp2f(a.y);
                        const f32x2 d = e + 1.0f; f32x2 sg; sg.x = __builtin_amdgcn_rcpf(d.x); sg.y = __builtin_amdgcn_rcpf(d.y);
                        const f32x2 o = (g * uu) * (sg * r2); w[2 * n + hf] = cvt_pk_bf16(o.x, o.y); }
                *(u32x4*)p = w; }
    }
};
struct EpiZ {
    static constexpr bool PERM = true, AFTER_DRAIN = false;
    bf16_t* O; int ldc; const float* SSQ; float* SSQC;
    static constexpr bool ROWSC = true;
    __device__ __forceinline__ void operator()(const f32x4 (&acc)[2][2][4][2], const Unit& u, int wr, int wc, int fr, int fq, const PG8_LAS float* rsl) const {
        asm volatile("" : "+v"(fr), "+v"(fq));
        const int row0 = u.pm * BM + wr * 64 + fr, col0 = u.pn * BM + wc * 32 + 8 * fq;
        float rr[2][4];
#pragma unroll
        for (int ai = 0; ai < 2; ++ai)
#pragma unroll
            for (int m = 0; m < 4; ++m) rr[ai][m] = rsl[wr * 64 + fr + ai * HALF + m * 16];
        asm volatile("" : "+v"(rr[0][0]), "+v"(rr[0][1]), "+v"(rr[0][2]), "+v"(rr[0][3]), "+v"(rr[1][0]), "+v"(rr[1][1]), "+v"(rr[1][2]), "+v"(rr[1][3]));
        const bool lowrank = u.pn >= 5 && u.pn <= 8;
#pragma unroll
        for (int ai = 0; ai < 2; ++ai)
#pragma unroll
            for (int m = 0; m < 4; ++m) { const int row = row0 + ai * HALF + m * 16; bf16_t* p = O + (size_t)row * ldc + col0;
                const float r = rr[ai][m]; float ss = 0.f;
#pragma unroll
                for (int bj = 0; bj < 2; ++bj) { const f32x4 v0 = acc[ai][bj][m][0] * r, v1 = acc[ai][bj][m][1] * r;
                    ss += ((v0[0] * v0[0] + v0[1] * v0[1]) + (v0[2] * v0[2] + v0[3] * v0[3])) + ((v1[0] * v1[0] + v1[1] * v1[1]) + (v1[2] * v1[2] + v1[3] * v1[3]));
                    u32x4 w; w.x = cvt_pk_bf16(v0[0], v0[1]); w.y = cvt_pk_bf16(v0[2], v0[3]); w.z = cvt_pk_bf16(v1[0], v1[1]); w.w = cvt_pk_bf16(v1[2], v1[3]);
                    *(u32x4*)(p + bj * HALF) = w; }
                if (lowrank) {
                    { float p0 = ss, p1 = ss; asm("s_nop 1\n\tv_permlane16_swap_b32 %0, %1" : "+v"(p0), "+v"(p1)); ss = p0 + p1; p0 = ss; p1 = ss; asm("s_nop 1\n\tv_permlane32_swap_b32 %0, %1" : "+v"(p0), "+v"(p1)); ss = p0 + p1; }
                    if (fq == 0) SSQC[(size_t)row * 16 + 4 * (u.pn - 5) + wc] = ss; } }
    }
};
struct DualOrder : StaticOrder {
    const char* A2; const char* B1; const char* B2;
    __device__ __forceinline__ bool next(int i, Unit& u) const {
        if (!StaticOrder::next(i, u)) return false;
        const size_t ta = (size_t)BM * lda * 2, tb = (size_t)BM * K * 2;
        if (u.pn < 6) { u.a = A + (size_t)u.pm * ta; u.b = B1 + (size_t)u.pn * tb; } else { u.a = A2 + (size_t)u.pm * ta; u.b = B2 + (size_t)(u.pn - 6) * tb; }
        return true;
    }
};
struct EpiQKV {
    static constexpr bool PERM = true, AFTER_DRAIN = false;
    bf16_t* OQ; bf16_t* OKV; const float* SSQC;
    __device__ __forceinline__ void operator()(const f32x4 (&acc)[2][2][4][2], const Unit& u, int wr, int wc, int fr, int fq) const {
        asm volatile("" : "+v"(fr), "+v"(fq));
        const bool isq = u.pn < 6; const int row0 = u.pm * BM + wr * 64 + fr, ldc = isq ? 1536 : 2048, col0 = (isq ? u.pn : u.pn - 6) * BM + wc * 32 + 8 * fq;
        bf16_t* base = isq ? OQ : OKV; const float* sq = SSQC + (isq ? 0 : 8);
        float rr[2][4];
#pragma unroll
        for (int ai = 0; ai < 2; ++ai)
#pragma unroll
            for (int m = 0; m < 4; ++m) { const f32x4* q = (const f32x4*)(sq + (size_t)(row0 + ai * HALF + m * 16) * 16); const f32x4 a = q[0] + q[1];
                rr[ai][m] = __builtin_amdgcn_rsqf(((a[0] + a[1]) + (a[2] + a[3])) * (1.0f / 512.0f) + 1e-6f); }
#pragma unroll
        for (int ai = 0; ai < 2; ++ai)
#pragma unroll
            for (int m = 0; m < 4; ++m) { const int row = row0 + ai * HALF + m * 16; bf16_t* p = base + (size_t)row * ldc + col0; const float r = rr[ai][m];
#pragma unroll
                for (int bj = 0; bj < 2; ++bj) { const f32x4 v0 = acc[ai][bj][m][0] * r, v1 = acc[ai][bj][m][1] * r;
                    u32x4 w; w.x = cvt_pk_bf16(v0[0], v0[1]); w.y = cvt_pk_bf16(v0[2], v0[3]); w.z = cvt_pk_bf16(v1[0], v1[1]); w.w = cvt_pk_bf16(v1[2], v1[3]);
                    *(u32x4*)(p + bj * HALF) = w; } }
    }
};
struct TailOrder {
    int c, S, K, nks; const char* A; const char* Bt;
    __device__ __forceinline__ void init(const Gemm& g, int S_, int c_) { c = c_; S = S_; K = g.K; nks = g.K / BK / S_; A = (const char*)g.A; Bt = (const char*)g.Bt; }
    __device__ __forceinline__ bool next(int i, Unit& u) const {
        const int xcd = c & 7, j = c >> 3; const size_t ts = (size_t)BM * K * 2;
        if (i == 0) { u.pm = xcd * 4 + (j >> 3); u.pn = j & 7; u.nk = K / BK; u.tag = 0; u.a = A + (size_t)u.pm * ts; u.b = Bt + (size_t)u.pn * ts; return true; }
        if (i == 1) { const int slice = xcd + 8 * (j >> 3); if (slice >= S) return false;
            u.pm = 32; u.pn = j & 7; u.nk = nks; u.tag = 0x200 | slice; u.a = A + 32 * ts + (size_t)slice * nks * (BK * 2); u.b = Bt + (size_t)u.pn * ts + (size_t)slice * nks * (BK * 2); return true; }
        return false;
    }
    __device__ __forceinline__ void a_ready(const Unit&) const {}
    __device__ __forceinline__ void done(const Unit&) const {}
};
struct BranchOrder {
    int c; const char* A0; const char* B0; size_t sA, sB;
    __device__ __forceinline__ bool next(int i, Unit& u) const {
        const int xcd = c & 7, j = c >> 3; const size_t ts = (size_t)BM * 1024 * 2;
        if (i < 3) { u.pm = xcd * 4 + (j >> 3); u.pn = j & 7; u.nk = 16; u.tag = i | (i ? 0x100 : 0);
            u.a = A0 + (size_t)i * sA + (size_t)u.pm * ts; u.b = B0 + (size_t)i * sB + (size_t)u.pn * ts; return true; }
        if (i == 3) { const int bs = xcd + 8 * (j >> 3); if (bs >= 12) return false; const int br = bs >> 2, slice = bs & 3;
            u.pm = 32; u.pn = j & 7; u.nk = 4; u.tag = 0x200 | bs;
            u.a = A0 + (size_t)br * sA + 32 * ts + slice * 512; u.b = B0 + (size_t)br * sB + (size_t)u.pn * ts + slice * 512; return true; }
        return false;
    }
    __device__ __forceinline__ void a_ready(const Unit&) const {}
    __device__ __forceinline__ void done(const Unit&) const {}
};
template <int S2  > struct EpiResidT {
    static constexpr bool PERM = false, AFTER_DRAIN = false; static constexpr float s = 0.5f * S2;
    float* H; float* PART; unsigned long long OUT  ;
    bf16_t* HB; float* SSQ;
    __device__ __forceinline__ void operator()(const f32x4 (&acc)[2][2][4][2], const Unit& u, int wr, int wc, int fr, int fq) const {
        asm volatile("" : "+v"(fr), "+v"(fq));
        if (u.tag & 0x200) {
            float* pb = PART + (size_t)(u.tag & 0xff) * (256 * 2048);
#pragma unroll
            for (int ai = 0; ai < 2; ++ai)
#pragma unroll
                for (int m = 0; m < 4; ++m) { const int lrow = ai * HALF + wr * 64 + m * 16 + fr;
#pragma unroll
                    for (int bj = 0; bj < 2; ++bj)
#pragma unroll
                        for (int n = 0; n < 2; ++n) { const int col = u.pn * BM + bj * HALF + wc * 32 + n * 16 + 4 * fq; *(f32x4*)(pb + (size_t)lrow * 2048 + col) = acc[ai][bj][m][n] * s; } }
            return;
        }
#pragma unroll
        for (int ai = 0; ai < 2; ++ai)
#pragma unroll
            for (int m = 0; m < 4; ++m) { const int row = u.pm * BM + ai * HALF + wr * 64 + m * 16 + fr; const int b = row >= 4224 ? 1 : 0, t = row - b * 4224; float ss = 0.f;
#pragma unroll
                for (int bj = 0; bj < 2; ++bj)
#pragma unroll
                    for (int n = 0; n < 2; ++n) { const int col = u.pn * BM + bj * HALF + wc * 32 + n * 16 + 4 * fq; float* p = H + (size_t)row * 2048 + col;
                        const f32x4 v = *(const f32x4*)p + acc[ai][bj][m][n] * s; *(f32x4*)p = v;
                        if (SSQ != nullptr) { typedef unsigned u32x2 __attribute__((ext_vector_type(2))); u32x2 w; w.x = cvt_pk_bf16(v[0], v[1]); w.y = cvt_pk_bf16(v[2], v[3]); *(u32x2*)(HB + (size_t)row * 2048 + col) = w;
                            ss += (v[0] * v[0] + v[1] * v[1]) + (v[2] * v[2] + v[3] * v[3]); }
                        if (OUT != 0ull && t >= 128) *(__attribute__((address_space(1))) f32x4*)(OUT + ((size_t)(b * 4096 + t - 128) * 2048 + col) * 4) = v; }
                if (SSQ != nullptr) {
                    { float p0 = ss, p1 = ss; asm("s_nop 1\n\tv_permlane16_swap_b32 %0, %1" : "+v"(p0), "+v"(p1)); ss = p0 + p1; p0 = ss; p1 = ss; asm("s_nop 1\n\tv_permlane32_swap_b32 %0, %1" : "+v"(p0), "+v"(p1)); ss = p0 + p1; }
                    if (fq == 0) SSQ[(size_t)row * 32 + 4 * u.pn + wc] = ss; }
                asm volatile("" ::: "memory"); }
    }
};
struct EpiGateR {
    static constexpr bool PERM = false, AFTER_DRAIN = false;
    const bf16_t* G; int ldg; bf16_t* MB; float* PART;
    static __device__ __forceinline__ float em(float x) { return __expf(-fminf(fmaxf(x, -30.f), 30.f)); }
    __device__ __forceinline__ void operator()(f32x4 (&acc)[2][2][4][2], const Unit& u, int wr, int wc, int fr, int fq) const {
        asm volatile("" : "+v"(fr), "+v"(fq));
        typedef unsigned u32x2 __attribute__((ext_vector_type(2)));
        const bool tail = (u.tag & 0x200) != 0; const int br = tail ? ((u.tag & 0xff) >> 2) : (u.tag & 3);
        float* pb = PART + (size_t)(u.tag & 0xff) * (256 * 2048);
        const bool resc = !tail && br < 2;
#pragma unroll
        for (int ai = 0; ai < 2; ++ai) {
            u32x2 gaa[4][2][2], gbb[4][2][2];
#pragma unroll
            for (int m = 0; m < 4; ++m)
#pragma unroll
                for (int bj = 0; bj < 2; ++bj)
#pragma unroll
                    for (int n = 0; n < 2; ++n) { const bf16_t* gp = G + (size_t)(u.pm * BM + ai * HALF + wr * 64 + m * 16 + fr) * ldg + br * 2048 + u.pn * BM + bj * HALF + wc * 32 + n * 16 + 4 * fq;
                        gaa[m][bj][n] = *(const u32x2*)gp; if (resc) gbb[m][bj][n] = *(const u32x2*)(gp + 2048); }
#pragma unroll
            for (int m = 0; m < 4; ++m) { const int lrow = ai * HALF + wr * 64 + m * 16 + fr, row = u.pm * BM + lrow;
#pragma unroll
                for (int bj = 0; bj < 2; ++bj)
#pragma unroll
                    for (int n = 0; n < 2; ++n) { const int col = u.pn * BM + bj * HALF + wc * 32 + n * 16 + 4 * fq;
                        const u32x2 ga = gaa[m][bj][n];
                        f32x4 ea; ea[0] = em(bf_lo(ga.x)); ea[1] = em(bf_hi(ga.x)); ea[2] = em(bf_lo(ga.y)); ea[3] = em(bf_hi(ga.y));
                        if (!resc) {
                            f32x4 v;
#pragma unroll
                            for (int e = 0; e < 4; ++e) v[e] = acc[ai][bj][m][n][e] * __builtin_amdgcn_rcpf(1.0f + ea[e]);
                            if (tail) *(f32x4*)(pb + (size_t)lrow * 2048 + col) = v;
                            else { u32x2 w; w.x = cvt_pk_bf16(v[0], v[1]); w.y = cvt_pk_bf16(v[2], v[3]); *(u32x2*)(MB + (size_t)row * 2048 + col) = w; }
                        } else {
                            const u32x2 gb = gbb[m][bj][n];
                            f32x4 eb; eb[0] = em(bf_lo(gb.x)); eb[1] = em(bf_hi(gb.x)); eb[2] = em(bf_lo(gb.y)); eb[3] = em(bf_hi(gb.y));
#pragma unroll
                            for (int e = 0; e < 4; ++e) acc[ai][bj][m][n][e] *= (1.0f + eb[e]) * __builtin_amdgcn_rcpf(1.0f + ea[e]);
                        } } }
            asm volatile("" ::: "memory"); }
    }
};
struct EpiNull {
    static constexpr bool PERM = true, AFTER_DRAIN = false;
    __device__ __forceinline__ void operator()(const f32x4 (&acc)[2][2][4][2], const Unit& u, int wr, int wc, int fr, int fq) const {
#pragma unroll
        for (int ai = 0; ai < 2; ++ai)
#pragma unroll
            for (int m = 0; m < 4; ++m) asm volatile("" :: "v"(acc[ai][0][m][0]), "v"(acc[ai][0][m][1]), "v"(acc[ai][1][m][0]), "v"(acc[ai][1][m][1]));
    }
};
struct SameTileOrder : StaticOrder {
    __device__ __forceinline__ bool next(int i, Unit& u) const { if (!StaticOrder::next(i, u)) return false; u.pm = 0; u.pn = 0; u.a = A; u.b = Bt; return true; }
};
constexpr int RS_LDS_OFF = 131904;
template <class T, class = void> struct rowsc_of { static constexpr bool v = false; };
template <class T> struct rowsc_of<T, decltype((void)T::ROWSC)> { static constexpr bool v = T::ROWSC; };
template <class Epi, class Sched, bool ALIGN_EPI = false, bool SP2 = false>
__device__ __forceinline__ void gemm_phase(PG8_LAS unsigned char* lds, const Gemm g, const Sched& S, const Epi& E, int tid_in) {
    int tid_ = tid_in; asm volatile("" : "+v"(tid_));
    const int tid = tid_, wid = __builtin_amdgcn_readfirstlane(tid >> 6), lane = tid & 63, wr = wid >> 2, wc = wid & 3, fr = lane & 15, fq = lane >> 4;
    const int K = g.K, LDA = g.lda;
    unsigned voffA[2], voffB[2];
#pragma unroll
    for (int i = 0; i < 2; ++i) { int R, C; stage_rc(tid * 16 + i * 8192, R, C); const int Rb = Epi::PERM ? ((R & ~31) + perm32(R & 31)) : R;
        voffA[i] = (unsigned)(R * LDA + C) * 2u; voffB[i] = (unsigned)(Rb * K + C) * 2u; }
    const size_t kstep = (size_t)(BK * 2);
    const size_t hstep = (size_t)HALF * K * 2, hstepA = (size_t)HALF * LDA * 2;
    const size_t tstep = 2 * hstep;
    const unsigned ldsw = (unsigned)wid * 1024u;
    const int aoff = lds_byte(wr * 64 + fr, fq * 8), boff = lds_byte(wc * 32 + fr, fq * 8);
#define PG8_SA(b, h) (((b) * 2 + (h)) * HTB)
#define PG8_SB(b, h) ((4 + (b) * 2 + (h)) * HTB)
#define PG8_STAGE(bufoff, gbase, voff) do { _Pragma("unroll") for (int _i = 0; _i < 2; ++_i) \
        __builtin_amdgcn_global_load_lds((const unsigned*)((const char*)(gbase) + (voff)[_i]), (PG8_LAS unsigned*)(lds + (bufoff) + ldsw + _i * 8192), 16, 0, 0); } while (0)
#define PG8_LDA(dst, b, h) do { _Pragma("unroll") for (int m = 0; m < 4; ++m) _Pragma("unroll") for (int k = 0; k < 2; ++k) dst[m][k] = *(const PG8_LAS bf16x8*)(lds + PG8_SA(b, h) + aoff + m * 2048 + k * 1024); } while (0)
#define PG8_LDB(dst, b, h) do { _Pragma("unroll") for (int n = 0; n < 2; ++n) _Pragma("unroll") for (int k = 0; k < 2; ++k) dst[n][k] = *(const PG8_LAS bf16x8*)(lds + PG8_SB(b, h) + boff + n * 2048 + k * 1024); } while (0)
#define PG8_MMA(ai, bj, At, Bt) do { __builtin_amdgcn_s_setprio(1); _Pragma("unroll") for (int m = 0; m < 4; ++m) _Pragma("unroll") for (int n = 0; n < 2; ++n) _Pragma("unroll") for (int k = 0; k < 2; ++k) \
        acc[ai][bj][m][n] = __builtin_amdgcn_mfma_f32_16x16x32_bf16(Bt[n][k], At[m][k], acc[ai][bj][m][n], 0, 0, 0); __builtin_amdgcn_s_setprio(0); } while (0)
#define PG8_WAIT_V(n) asm volatile("s_waitcnt vmcnt(" #n ")" ::: "memory")
#define PG8_WAIT_L(n) asm volatile("s_waitcnt lgkmcnt(" #n ")" ::: "memory")
#define PG8_BAR __builtin_amdgcn_s_barrier()
#define PG8_SCHED __builtin_amdgcn_sched_barrier(0)
    Unit cur, nxt; int ui = 0;
    if (!S.next(0, cur)) return;
    f32x4 acc[2][2][4][2];
#pragma unroll
    for (int a = 0; a < 2; ++a)
#pragma unroll
        for (int b = 0; b < 2; ++b)
#pragma unroll
            for (int m = 0; m < 4; ++m)
#pragma unroll
                for (int n = 0; n < 2; ++n) acc[a][b][m][n] = (f32x4){0.f, 0.f, 0.f, 0.f};
    bf16x8 At[4][2], B0[2][2], B1[2][2];
    const char* cA = cur.a; const char* cB = cur.b;
    S.a_ready(cur);
    if constexpr (SP2) {
        PG8_STAGE(PG8_SB(0, 0), cB, voffB); PG8_STAGE(PG8_SB(0, 1), cB + hstep, voffB); PG8_STAGE(PG8_SA(0, 0), cA, voffA); PG8_STAGE(PG8_SA(0, 1), cA + hstepA, voffA);
        if (wr == 1) PG8_BAR;
        PG8_WAIT_V(2); PG8_BAR;
        PG8_STAGE(PG8_SB(1, 0), cB + kstep, voffB); PG8_STAGE(PG8_SA(1, 0), cA + kstep, voffA); PG8_STAGE(PG8_SB(1, 1), cB + hstep + kstep, voffB);
        PG8_WAIT_V(6); PG8_BAR;
    } else {
        PG8_STAGE(PG8_SB(0, 0), cB, voffB); PG8_STAGE(PG8_SA(0, 0), cA, voffA); PG8_STAGE(PG8_SB(0, 1), cB + hstep, voffB); PG8_STAGE(PG8_SA(0, 1), cA + hstepA, voffA);
        if (wr == 1) PG8_BAR;
        PG8_WAIT_V(4); PG8_BAR;
        PG8_STAGE(PG8_SB(1, 0), cB + kstep, voffB); PG8_STAGE(PG8_SA(1, 0), cA + kstep, voffA); PG8_STAGE(PG8_SB(1, 1), cB + hstep + kstep, voffB);
        PG8_WAIT_V(6); PG8_BAR;
    }
    for (;;) {
        const bool has_next = S.next(ui + 1, nxt);
        const char* nA = has_next ? nxt.a : cA; const char* nB = has_next ? nxt.b : cB;
        const int nt = cur.nk;
        if constexpr (rowsc_of<Epi>::v) __builtin_amdgcn_global_load_lds((const unsigned*)(E.SSQ + cur.pm * BM + lane * 4), (PG8_LAS unsigned*)(lds + RS_LDS_OFF + wid * 1024), 16, 0, 0);
        for (int t = 0; t < nt; t += 2) {
            const bool last = (t == nt - 2);
            const char* a1 = cA + (size_t)(t + 1) * kstep;
            const char* a2 = last ? nA : cA + (size_t)(t + 2) * kstep; const char* b2 = last ? nB : cB + (size_t)(t + 2) * kstep;
            const char* a3 = a2 + kstep; const char* b3 = b2 + kstep;
            if (last && has_next) S.a_ready(nxt);
            if constexpr (SP2) {
            PG8_LDB(B0, 0, 0); PG8_LDB(B1, 0, 1); PG8_SCHED; PG8_LDA(At, 0, 0); PG8_STAGE(PG8_SA(1, 1), a1 + hstepA, voffA);
            PG8_WAIT_V(8); PG8_WAIT_L(0); PG8_BAR; PG8_MMA(0, 0, At, B0); PG8_MMA(0, 1, At, B1); PG8_BAR; PG8_SCHED;
            PG8_LDA(At, 0, 1); PG8_STAGE(PG8_SB(0, 0), b2, voffB); PG8_STAGE(PG8_SB(0, 1), b2 + hstep, voffB); PG8_STAGE(PG8_SA(0, 0), a2, voffA);
            PG8_WAIT_V(8); PG8_WAIT_L(0); PG8_BAR; PG8_MMA(1, 0, At, B0); PG8_MMA(1, 1, At, B1); PG8_BAR; PG8_SCHED;
            PG8_LDB(B0, 1, 0); PG8_LDB(B1, 1, 1); PG8_SCHED; PG8_LDA(At, 1, 0); PG8_STAGE(PG8_SA(0, 1), a2 + hstepA, voffA);
            PG8_WAIT_V(8); PG8_WAIT_L(0); PG8_BAR; PG8_MMA(0, 0, At, B0); PG8_MMA(0, 1, At, B1); PG8_BAR; PG8_SCHED;
            PG8_LDA(At, 1, 1); PG8_STAGE(PG8_SB(1, 0), b3, voffB); PG8_STAGE(PG8_SB(1, 1), b3 + hstep, voffB); PG8_STAGE(PG8_SA(1, 0), a3, voffA);
            PG8_WAIT_V(8); PG8_WAIT_L(0); PG8_BAR; PG8_MMA(1, 0, At, B0); PG8_MMA(1, 1, At, B1); PG8_BAR; PG8_SCHED;
            } else {
            PG8_LDB(B0, 0, 0); PG8_SCHED; PG8_LDA(At, 0, 0); PG8_STAGE(PG8_SA(1, 1), a1 + hstepA, voffA);
            PG8_WAIT_L(8); PG8_BAR; PG8_WAIT_L(0); PG8_MMA(0, 0, At, B0); PG8_BAR; PG8_SCHED;
            PG8_LDB(B1, 0, 1); PG8_STAGE(PG8_SB(0, 0), b2, voffB);
            PG8_BAR; PG8_WAIT_L(0); PG8_MMA(0, 1, At, B1); PG8_BAR;
            PG8_LDA(At, 0, 1); PG8_STAGE(PG8_SA(0, 0), a2, voffA);
            PG8_BAR; PG8_WAIT_L(0); PG8_MMA(1, 0, At, B0); PG8_BAR; PG8_SCHED;
            PG8_STAGE(PG8_SB(0, 1), b2 + hstep, voffB);
            PG8_WAIT_V(6); PG8_BAR; PG8_MMA(1, 1, At, B1); PG8_BAR;
            PG8_LDB(B0, 1, 0); PG8_SCHED; PG8_LDA(At, 1, 0); PG8_STAGE(PG8_SA(0, 1), a2 + hstepA, voffA);
            PG8_WAIT_L(8); PG8_BAR; PG8_WAIT_L(0); PG8_MMA(0, 0, At, B0); PG8_BAR; PG8_SCHED;
            PG8_LDB(B1, 1, 1); PG8_STAGE(PG8_SB(1, 0), b3, voffB);
            PG8_BAR; PG8_WAIT_L(0); PG8_MMA(0, 1, At, B1); PG8_BAR;
            PG8_LDA(At, 1, 1); PG8_STAGE(PG8_SA(1, 0), a3, voffA);
            PG8_BAR; PG8_WAIT_L(0); PG8_MMA(1, 0, At, B0); PG8_BAR; PG8_SCHED;
            PG8_STAGE(PG8_SB(1, 1), b3 + hstep, voffB);
            PG8_WAIT_V(6); PG8_BAR; PG8_MMA(1, 1, At, B1); PG8_BAR;
            }
        }
        if constexpr (ALIGN_EPI) { if (wr == 0) PG8_BAR; }
        if constexpr (rowsc_of<Epi>::v) { E(acc, cur, wr, wc, fr, fq, (const PG8_LAS float*)(lds + RS_LDS_OFF + wid * 1024)); S.done(cur); }
        else if constexpr (!Epi::AFTER_DRAIN) { E(acc, cur, wr, wc, fr, fq); S.done(cur); }
        if (!has_next) break;
        if (!(nxt.tag & 0x100)) {
#pragma unroll
        for (int a = 0; a < 2; ++a)
#pragma unroll
            for (int b = 0; b < 2; ++b)
#pragma unroll
                for (int m = 0; m < 4; ++m)
#pragma unroll
                    for (int n = 0; n < 2; ++n) acc[a][b][m][n] = (f32x4){0.f, 0.f, 0.f, 0.f};
        }
        cur = nxt; cA = nA; cB = nB; ++ui;
        if constexpr (ALIGN_EPI) { if (wr == 1) PG8_BAR; }
    }
    PG8_WAIT_V(0);
    if constexpr (!ALIGN_EPI) { if (wr == 0) PG8_BAR; }
    PG8_BAR;
    if constexpr (Epi::AFTER_DRAIN) { E.fused(acc, cur, wr, wc, fr, fq, lds, wid, lane); S.done(cur); }
#undef PG8_SA
#undef PG8_SB
#undef PG8_STAGE
#undef PG8_LDA
#undef PG8_LDB
#undef PG8_MMA
#undef PG8_WAIT_V
#undef PG8_WAIT_L
#undef PG8_BAR
#undef PG8_SCHED
}
}
constexpr int NWAVES = 8;
constexpr int D = 2048, NB = 2, SEQ = 4096, LP = 4224, M = NB * LP, DEPTH = 4, FF = 5632, NGU = 2 * FF, NIN = 11584, NINP = 11776;
constexpr int OQ = 0, OSK = 1024, OSV = 1152, OCQ = 1280, OCKV = 1792, OKR = 2304, ORQ = 2368, ORK = 2880, ORV = 3392, ORG = 4416, OG = 5440;
constexpr int PADR = 112;
constexpr float EPS = 1e-6f, LOG2E = 1.44269504088896f;
constexpr float SWA_QS = 0.125f * LOG2E, MLA_QS = 0.07216878364870322f * LOG2E, RET_KS = 0.08838834764831845f;
constexpr size_t MiB = 1u << 20;
constexpr size_t WS_CTL = 0, CTL_ZERO_BYTES = 1 * MiB;
constexpr size_t WS_C64 = 1 * MiB, WS_S64 = WS_C64 + (size_t)LP * 64 * 4, WS_C32 = WS_S64 + (size_t)LP * 64 * 4, WS_S32 = WS_C32 + (size_t)LP * 32 * 4;
constexpr size_t WS_W = 5 * MiB;
constexpr size_t W_GU1 = WS_W, W_D1 = WS_W + 44 * MiB, W_IN = WS_W + 66 * MiB, W_UQ = WS_W + 112 * MiB, W_UKV = WS_W + 114 * MiB, W_BS = WS_W + 116 * MiB, W_BM = WS_W + 120 * MiB,
                 W_BR = WS_W + 124 * MiB, W_O = WS_W + 128 * MiB, W_GU2 = WS_W + 136 * MiB, W_D2 = WS_W + 180 * MiB;
constexpr size_t WS_H = 208 * MiB, WS_HN = 274 * MiB, WS_ACT = 307 * MiB, WS_Z = 398 * MiB, WS_QS = 588 * MiB, WS_KS = 605 * MiB, WS_CQN = 608 * MiB, WS_CKVN = 617 * MiB,
                 WS_QRAW = 626 * MiB, WS_KVRAW = 651 * MiB, WS_QM = 684 * MiB, WS_KM = 709 * MiB, WS_RQ = 734 * MiB, WS_RK = 743 * MiB, WS_OA = 752 * MiB, WS_OB = 769 * MiB,
                 WS_OC = 786 * MiB, WS_MF = 803 * MiB, WS_MB = 869 * MiB, WS_KVC = 902 * MiB, WS_PREV = 935 * MiB, WS_PART = 952 * MiB, WS_SSQ = 996 * MiB, WS_RS = 1010 * MiB, WS_SSQC = 1011 * MiB, WS_END = 1012 * MiB;
static_assert(WS_S32 + (size_t)LP * 32 * 4 <= WS_W, "rope tables");
static_assert(W_D2 + (size_t)D * FF * 2 <= WS_H && W_IN + (size_t)NINP * D * 2 <= W_UQ && W_GU1 + (size_t)NGU * D * 2 <= W_D1, "weights");
static_assert(WS_Z + (size_t)M * NINP * 2 <= WS_QS && WS_ACT + (size_t)M * FF * 2 <= WS_Z && WS_H + (size_t)M * D * 4 <= WS_HN, "acts");
constexpr int CW_BAR = 4096;
constexpr int RING_BYTES = 131072, LDSCTL_OFF = RING_BYTES, MISC_OFF = LDSCTL_OFF + 320, PTAB_OFF = MISC_OFF + 256, RSL_OFF = PTAB_OFF + 256, LDS_BYTES = 147456;
static_assert(RSL_OFF == pg8::RS_LDS_OFF && RSL_OFF + 8 * 1024 <= LDS_BYTES, "row-scale slots");

#define GAS __attribute__((address_space(1)))
#define LAS __attribute__((address_space(3)))
typedef unsigned short bf16;
typedef unsigned v4u __attribute__((ext_vector_type(4)));
typedef unsigned v2u __attribute__((ext_vector_type(2)));
typedef float f32x4 __attribute__((ext_vector_type(4)));
typedef const GAS float* gfp;
__device__ __forceinline__ gfp in_ptr(LAS unsigned char* lds, int i) { const LAS unsigned* t = (const LAS unsigned*)(lds + PTAB_OFF) + 2 * i; const unsigned lo = __builtin_amdgcn_readfirstlane(t[0]), hi = __builtin_amdgcn_readfirstlane(t[1]); return (gfp)(((unsigned long long)hi << 32) | lo); }
#define LDS_WAIT() asm volatile("s_waitcnt lgkmcnt(0)" ::: "memory")
__device__ __forceinline__ unsigned f2bf(float f) { unsigned u = __builtin_bit_cast(unsigned, f); return (u + 0x7fffu + ((u >> 16) & 1u)) >> 16; }
__device__ __forceinline__ unsigned pk2(float lo, float hi) { unsigned r; asm("v_cvt_pk_bf16_f32 %0, %1, %2" : "=v"(r) : "v"(lo), "v"(hi)); return r; }
__device__ __forceinline__ float bf2f(bf16 v) { return __builtin_bit_cast(float, (unsigned)v << 16); }
__device__ __forceinline__ float blo(unsigned w) { return __builtin_bit_cast(float, w << 16); }
__device__ __forceinline__ float bhi(unsigned w) { return __builtin_bit_cast(float, w & 0xffff0000u); }
__device__ __forceinline__ float ex2(float x) { return __builtin_amdgcn_exp2f(x); }
template <int O> __device__ __forceinline__ float sxor(float v, int lane) {
    if constexpr (O < 32) return __builtin_bit_cast(float, __builtin_amdgcn_ds_swizzle(__builtin_bit_cast(int, v), (O << 10) | 0x1f));
    else return __builtin_bit_cast(float, __builtin_amdgcn_ds_bpermute((lane ^ 32) << 2, __builtin_bit_cast(int, v)));
}
#define SWAP_PAIR(which, v) float r0 = (v), r1 = (v); asm("s_nop 1\n\tv_permlane" #which "_swap_b32 %0, %1" : "+v"(r0), "+v"(r1));
__device__ __forceinline__ float radd16(float v) { SWAP_PAIR(16, v) return r0 + r1; }
__device__ __forceinline__ float radd32(float v) { SWAP_PAIR(32, v) return r0 + r1; }
__device__ __forceinline__ float rmax16(float v) { SWAP_PAIR(16, v) return fmaxf(r0, r1); }
__device__ __forceinline__ float rmax32(float v) { SWAP_PAIR(32, v) return fmaxf(r0, r1); }
template <int CTRL> __device__ __forceinline__ float dpp_f(float v) { return __builtin_bit_cast(float, __builtin_amdgcn_mov_dpp(__builtin_bit_cast(int, v), CTRL, 0xF, 0xF, true)); }
__device__ __forceinline__ float wave_sum(float v, int lane) {
    v += dpp_f<0xB1>(v); v += dpp_f<0x4E>(v); v += dpp_f<0x141>(v); v += dpp_f<0x140>(v); v = radd32(radd16(v));
    return v;
}
template <int N> __device__ __forceinline__ float grp_sum(float v, int lane) {
    static_assert(N == 4 || N == 8, "grp_sum");
    v += dpp_f<0xB1>(v); v += dpp_f<0x4E>(v);
    if constexpr (N == 8) v += dpp_f<0x141>(v);
    return v;
}
#define XB_TMO      128
#define XB_XCNT(j)  (256  + 64 * (j))
#define XB_XSUB(j)  (1280 + 64 * (j))
#define XB_XGEN(j)  (2304 + 64 * (j))
#define XB_TOP      3328
#define XB_TOPGEN   3392
#define XCD_BAR_WORDS 3456
#define XB_SPIN_CAP (1u << 18)

__device__ __forceinline__ unsigned xb_ld(unsigned* p)              { return __hip_atomic_load(p, __ATOMIC_RELAXED, __HIP_MEMORY_SCOPE_AGENT); }
__device__ __forceinline__ unsigned xb_add(unsigned* p, unsigned v) { return __hip_atomic_fetch_add(p, v, __ATOMIC_RELAXED, __HIP_MEMORY_SCOPE_AGENT); }
__device__ __forceinline__ unsigned xb_xcc_id() { return (unsigned)__builtin_amdgcn_s_getreg((3 << 11) | 20) & 0xFu; }
#define XB_SPIN(cond, bar) do { unsigned _sp = 0; while (cond) { __builtin_amdgcn_s_sleep(1); \
    if ((++_sp & 255u) == 0u) { if (xb_ld(&(bar)[XB_TMO])) break; if (_sp > XB_SPIN_CAP) { atomicAdd(&(bar)[XB_TMO], 1u); break; } } } } while (0)

struct XcdBarrier {
    unsigned* bar; unsigned x; int w0; unsigned zz  ;
    volatile LAS unsigned* st;
};

__device__ __forceinline__ XcdBarrier xcd_barrier_post(unsigned* bar, volatile LAS unsigned* st) {
    XcdBarrier b; b.bar = bar; b.x = xb_xcc_id(); b.st = st; b.w0 = __builtin_amdgcn_readfirstlane((int)(threadIdx.x >> 6)); b.zz = 0u;
    if (threadIdx.x == 0) (void)xb_add(&bar[XB_XCNT(b.x)], 1u);
    return b;
}
__device__ __forceinline__ void xcd_barrier_complete(unsigned* bar, unsigned x, unsigned& nloc, unsigned& nx) {
    const unsigned G = gridDim.x * gridDim.y * gridDim.z;
    unsigned sum, cnt, mine, sp = 0u;
    for (;;) {
        sum = 0u; cnt = 0u; mine = 0u;
#pragma unroll
        for (unsigned j = 0; j < 16; ++j) { const unsigned c = xb_ld(&bar[XB_XCNT(j)]); sum += c; cnt += (c > 0u) ? 1u : 0u; mine = (j == x) ? c : mine; }
        if (sum == G) break;
        __builtin_amdgcn_s_sleep(1);
        if ((++sp & 255u) == 0u) { if (xb_ld(&bar[XB_TMO])) break; if (sp > XB_SPIN_CAP) { atomicAdd(&bar[XB_TMO], 1u); break; } }
    }
    nloc = mine > 0u ? mine : 1u; nx = cnt > 0u ? cnt : 1u;
}

__device__ __forceinline__ void xcd_barrier(const XcdBarrier& b) {
    asm volatile("s_waitcnt vmcnt(0)" ::: "memory");
    __syncthreads();
    if (b.w0 == 0 && __builtin_amdgcn_mbcnt_hi(~0u, __builtin_amdgcn_mbcnt_lo(~0u, b.zz)) == 0u) {
        unsigned* bar = b.bar;
        __builtin_amdgcn_s_waitcnt(0);
        unsigned nloc = b.st[0], nx = b.st[1];
        if (nloc == 0u) { xcd_barrier_complete(bar, b.x, nloc, nx); b.st[0] = nloc; b.st[1] = nx; }
        const unsigned old = xb_add(&bar[XB_XSUB(b.x)], 1u);
        const unsigned gen = old / nloc;
        if (old + 1u == (gen + 1u) * nloc) {
            __builtin_amdgcn_fence(__ATOMIC_RELEASE, "agent");
            asm volatile("s_waitcnt vmcnt(0)" ::: "memory");
            const unsigned og = xb_add(&bar[XB_TOP], 1u);
            const unsigned tg = og / nx;
            if (og + 1u == (tg + 1u) * nx) xb_add(&bar[XB_TOPGEN], 1u);
            else XB_SPIN(xb_ld(&bar[XB_TOPGEN]) == tg, bar);
            __builtin_amdgcn_fence(__ATOMIC_ACQUIRE, "agent");
            xb_add(&bar[XB_XGEN(b.x)], 1u);
            asm volatile("s_waitcnt vmcnt(0)" ::: "memory");
        } else {
            XB_SPIN(xb_ld(&bar[XB_XGEN(b.x)]) == gen, bar);
            __builtin_amdgcn_fence(__ATOMIC_ACQUIRE, "agent");
            asm volatile("s_waitcnt vmcnt(0)" ::: "memory");
        }
    }
    __syncthreads();
}
__device__ __forceinline__ void unpack8(const v4u w, float* f) { f[0] = blo(w.x); f[1] = bhi(w.x); f[2] = blo(w.y); f[3] = bhi(w.y); f[4] = blo(w.z); f[5] = bhi(w.z); f[6] = blo(w.w); f[7] = bhi(w.w); }
__device__ __forceinline__ v4u pack8(const float* f) { v4u w; w.x = pk2(f[0], f[1]); w.y = pk2(f[2], f[3]); w.z = pk2(f[4], f[5]); w.w = pk2(f[6], f[7]); return w; }

__device__ __forceinline__ void cvt_item(gfp W, int N, bf16* WT, int Kd, int k0, int n0, int drow0, LAS float* scr, int lane, gfp gk) {
#pragma unroll 8
    for (int i = 0; i < 32; ++i) { const int kk = 2 * i + (lane >> 5); scr[kk * 33 + (lane & 31)] = W[(size_t)(k0 + kk) * N + n0 + (lane & 31)]; }
    const int c = lane & 7;
    f32x4 ga = (f32x4){1.f, 1.f, 1.f, 1.f}, gb = ga;
    if (gk != nullptr) { ga = *(const GAS f32x4*)(gk + k0 + 8 * c); gb = *(const GAS f32x4*)(gk + k0 + 8 * c + 4); }
    LDS_WAIT(); asm volatile("" ::: "memory");
#pragma unroll
    for (int j = 0; j < 4; ++j) { const int n = (lane >> 3) + 8 * j; const LAS float* s = scr + (8 * c) * 33 + n;
        v4u o; o.x = pk2(s[0 * 33] * ga[0], s[1 * 33] * ga[1]); o.y = pk2(s[2 * 33] * ga[2], s[3 * 33] * ga[3]); o.z = pk2(s[4 * 33] * gb[0], s[5 * 33] * gb[1]); o.w = pk2(s[6 * 33] * gb[2], s[7 * 33] * gb[3]);
        *(GAS v4u*)(WT + (size_t)(drow0 + n) * Kd + k0 + 8 * c) = o; }
    LDS_WAIT(); asm volatile("" ::: "memory");
}
__device__ __forceinline__ void cvt_plain(gfp W, int K, int N, bf16* WT, int item, LAS float* scr, int lane, gfp gk) {
    const int nblk = N / 32, kb = item / nblk, nb = item % nblk;
    cvt_item(W, N, WT, K, 64 * kb, 32 * nb, 32 * nb, scr, lane, gk);
}
__device__ __forceinline__ void cvt_gu(gfp W, bf16* WT, int half, int item, LAS float* scr, int lane, gfp gk) {
    const int nblk = FF / 32, kb = item / nblk, nb = item % nblk, n0 = 32 * nb;
    cvt_item(W, FF, WT, D, 64 * kb, n0, 256 * (n0 >> 7) + 128 * half + (n0 & 127), scr, lane, gk);
}

__device__ __forceinline__ void fix_row(float* hrow, bf16* hb, float* rout, int lane, const float* part, int nparts) {
    f32x4 v[8]; float ss = 0.f;
#pragma unroll
    for (int j = 0; j < 8; ++j) v[j] = *(const f32x4*)(hrow + 4 * lane + 256 * j);
    if (part != nullptr) {
        for (int s = 0; s < nparts; ++s) {
#pragma unroll
            for (int j = 0; j < 8; ++j) v[j] = v[j] + *(const f32x4*)(part + (size_t)s * (256 * 2048) + 4 * lane + 256 * j); }
#pragma unroll
        for (int j = 0; j < 8; ++j) *(f32x4*)(hrow + 4 * lane + 256 * j) = v[j];
    }
#pragma unroll
    for (int j = 0; j < 8; ++j) { ss += (v[j].x * v[j].x + v[j].y * v[j].y) + (v[j].z * v[j].z + v[j].w * v[j].w);
        v2u w; w.x = pk2(v[j].x, v[j].y); w.y = pk2(v[j].z, v[j].w); *(v2u*)(hb + 4 * lane + 256 * j) = w; }
    ss = wave_sum(ss, lane);
    if (lane == 0) *rout = __builtin_amdgcn_rsqf(ss * (1.0f / D) + EPS);
}
__device__ __forceinline__ void row_scales(const float* ssq32, float* rout, int gt, int NGT) {
    for (int row = gt; row < 8192; row += NGT) { const f32x4* q = (const f32x4*)(ssq32 + (size_t)row * 32); f32x4 a = q[0];
#pragma unroll
        for (int i = 1; i < 8; ++i) a = a + q[i];
        rout[row] = __builtin_amdgcn_rsqf(((a[0] + a[1]) + (a[2] + a[3])) * (1.0f / D) + EPS); }
}
template <int NP> __device__ __forceinline__ void fix_panel32(float* Hh, bf16* Hb, float* rs_out, const float* part, volatile LAS float* red, int tid, int lane, int wave) {
    for (int lrow = blockIdx.x; lrow < 256; lrow += gridDim.x) {
        const int col = 256 * wave + 4 * lane; const size_t ro = (size_t)(8192 + lrow) * D + col;
        f32x4 v = *(const f32x4*)(Hh + ro); f32x4 p[NP];
#pragma unroll
        for (int s = 0; s < NP; ++s) p[s] = *(const f32x4*)(part + ((size_t)s * 256 + lrow) * 2048 + col);
#pragma unroll
        for (int s = 0; s < NP; ++s) v = v + p[s];
        *(f32x4*)(Hh + ro) = v;
        v2u w; w.x = pk2(v.x, v.y); w.y = pk2(v.z, v.w); *(v2u*)(Hb + ro) = w;
        const float ss = wave_sum((v.x * v.x + v.y * v.y) + (v.z * v.z + v.w * v.w), lane);
        if (lane == 0) red[wave] = ss;
        __syncthreads();
        if (tid == 0) { const float t = ((red[0] + red[1]) + (red[2] + red[3])) + ((red[4] + red[5]) + (red[6] + red[7])); rs_out[lrow] = __builtin_amdgcn_rsqf(t * (1.0f / D) + EPS); }
        __syncthreads();
    }
}
typedef short bf16x8 __attribute__((ext_vector_type(8)));
typedef short s16x4 __attribute__((ext_vector_type(4)));
typedef short v4i16_t __attribute__((ext_vector_type(4)));
__device__ __forceinline__ s16x4 tr_read(LAS const unsigned char* p) { return __builtin_bit_cast(s16x4, __builtin_amdgcn_ds_read_tr16_b64_v4i16((LAS v4i16_t*)p)); }
__device__ __forceinline__ bf16x8 cat4(s16x4 a, s16x4 b) { bf16x8 r; r[0] = a[0]; r[1] = a[1]; r[2] = a[2]; r[3] = a[3]; r[4] = b[0]; r[5] = b[1]; r[6] = b[2]; r[7] = b[3]; return r; }
__device__ __forceinline__ bf16x8 pack_p(const f32x4 a, const f32x4 b) { v4u w; w.x = pk2(a[0], a[1]); w.y = pk2(a[2], a[3]); w.z = pk2(b[0], b[1]); w.w = pk2(b[2], b[3]); return __builtin_bit_cast(bf16x8, w); }
__device__ __forceinline__ float max3f(float a, float b, float c) { float r; asm("v_max3_f32 %0, %1, %2, %3" : "=v"(r) : "v"(a), "v"(b), "v"(c)); return r; }
__device__ __forceinline__ float max8f(const f32x4 a, const f32x4 b) { return max3f(max3f(a[0], a[1], a[2]), max3f(a[3], b[0], b[1]), max3f(b[2], b[3], b[3])); }
#define MFMA16(a, b, c) __builtin_amdgcn_mfma_f32_16x16x32_bf16((a), (b), (c), 0, 0, 0)

__device__ __forceinline__ int pop_unit(unsigned* ctr, volatile LAS unsigned* slot, int tid) {
    __syncthreads();
    if (tid == 0) *slot = __hip_atomic_fetch_add(ctr, 1u, __ATOMIC_RELAXED, __HIP_MEMORY_SCOPE_AGENT);
    __syncthreads();
    return (int)*slot;
}

template <int DQK, int DV, int MODE>
__device__ __forceinline__ void flash_unit(LAS unsigned char* lds, const bf16* Q, int ldq, const bf16* K, int ldk, const bf16* V, int ldv, bf16* O, int ldo, int qb, float sink_l2, int tid) {
    constexpr int SK = DQK * 2 + 16, SV = DV * 2 + 16, KB = 64 * SK, VB = 64 * SV, BUF = KB + VB;
    constexpr int KCH = DQK / 8, VCH = DV / 8, NKC = 64 * KCH / 512, NVC = 64 * VCH / 512, NKS = DQK / 32, NDV = DV / 16;
    static_assert(64 * KCH % 512 == 0 && 64 * VCH % 512 == 0 && 2 * BUF <= RING_BYTES, "flash tile geometry");
    const int lane = tid & 63, w = __builtin_amdgcn_readfirstlane(tid >> 6), g = lane >> 4, c16 = lane & 15;
    const int q0 = qb * 128, qrow = q0 + 16 * w + c16;
    const int first2 = MODE == 0 ? 2 : ((2 * qb - 2) > 2 ? (2 * qb - 2) : 2);
    const int nt = MODE == 0 ? 2 * qb + 1 : 1 + ((2 * qb + 2 - first2) > 0 ? (2 * qb + 2 - first2) : 0);
#define FL_KT(it) ((it) == 0 ? 1 : first2 + (it) - 1)
    bf16x8 qf[NKS];
#pragma unroll
    for (int ks = 0; ks < NKS; ++ks) qf[ks] = *(const bf16x8*)(Q + (size_t)qrow * ldq + 32 * ks + 8 * g);
    v4u kr[2][NKC], vr[2][NVC];
#define FL_LOAD(kt, P) do { const int key0_ = 64 * (kt); \
        _Pragma("unroll") for (int j = 0; j < NKC; ++j) { const int c = tid + 512 * j, r = c / KCH, cc = c % KCH; kr[P][j] = *(const v4u*)(K + (size_t)(key0_ + r) * ldk + cc * 8); } \
        _Pragma("unroll") for (int j = 0; j < NVC; ++j) { const int c = tid + 512 * j, r = c / VCH, cc = c % VCH; vr[P][j] = *(const v4u*)(V + (size_t)(key0_ + r) * ldv + cc * 8); } } while (0)
#define FL_STORE(buf, P) do { \
        _Pragma("unroll") for (int j = 0; j < NKC; ++j) { const int c = tid + 512 * j, r = c / KCH, cc = c % KCH; *(LAS v4u*)(lds + (buf) * BUF + r * SK + cc * 16) = kr[P][j]; } \
        _Pragma("unroll") for (int j = 0; j < NVC; ++j) { const int c = tid + 512 * j, r = c / VCH, cc = c % VCH; *(LAS v4u*)(lds + (buf) * BUF + KB + r * SV + cc * 16) = vr[P][j]; } } while (0)
    f32x4 acc_o[NDV];
#pragma unroll
    for (int n = 0; n < NDV; ++n) acc_o[n] = (f32x4){0.f, 0.f, 0.f, 0.f};
    float m = -1e30f, l = 0.f;
    FL_LOAD(FL_KT(0), 0);
    if (nt > 1) FL_LOAD(FL_KT(1), 1);
    for (int it2 = 0; it2 < nt; it2 += 2) {
#pragma unroll
        for (int P = 0; P < 2; ++P) {
        const int it = it2 + P;
        if (it < nt) {
        const int buf = P, key0 = 64 * FL_KT(it);
        FL_STORE(buf, P);
        __syncthreads();
        if (it + 2 < nt) FL_LOAD(FL_KT(it + 2), P);
        const LAS unsigned char* kb = lds + buf * BUF; const LAS unsigned char* vb = kb + KB;
        f32x4 s[4];
#pragma unroll
        for (int t = 0; t < 4; ++t) { s[t] = (f32x4){0.f, 0.f, 0.f, 0.f};
#pragma unroll
            for (int ks = 0; ks < NKS; ++ks) { const bf16x8 kf = *(const LAS bf16x8*)(kb + (16 * t + c16) * SK + (32 * ks + 8 * g) * 2); s[t] = MFMA16(kf, qf[ks], s[t]); } }
        const bool need_mask = MODE == 1 || key0 < 128 || key0 + 63 > q0 + 16 * w;
        if (need_mask) {
#pragma unroll
            for (int t = 0; t < 4; ++t)
#pragma unroll
                for (int r = 0; r < 4; ++r) { const int k = key0 + 16 * t + 4 * g + r;
                    bool vis = k >= PADR && k <= qrow; if (MODE == 1) vis = vis && (qrow - k < 128 || k < 128);
                    if (!vis) s[t][r] = -1e30f; }
        }
        float mx = fmaxf(fmaxf(fmaxf(s[0][0], s[0][1]), fmaxf(s[0][2], s[0][3])), fmaxf(fmaxf(s[1][0], s[1][1]), fmaxf(s[1][2], s[1][3])));
        mx = fmaxf(mx, fmaxf(fmaxf(fmaxf(s[2][0], s[2][1]), fmaxf(s[2][2], s[2][3])), fmaxf(fmaxf(s[3][0], s[3][1]), fmaxf(s[3][2], s[3][3]))));
        mx = rmax32(rmax16(mx));
        const float mn = fmaxf(m, mx), al = ex2(m - mn); m = mn;
        float ps = 0.f;
#pragma unroll
        for (int t = 0; t < 4; ++t)
#pragma unroll
            for (int r = 0; r < 4; ++r) { s[t][r] = ex2(s[t][r] - mn); ps += s[t][r]; }
        l = l * al + ps;
        if (!__all(al == 1.0f)) {
#pragma unroll
            for (int n = 0; n < NDV; ++n) acc_o[n] = acc_o[n] * al; }
#pragma unroll
        for (int tp = 0; tp < 2; ++tp) { const bf16x8 pf = pack_p(s[2 * tp], s[2 * tp + 1]);
            const LAS unsigned char* v0 = vb + (32 * tp + 4 * g + (c16 >> 2)) * SV + (4 * (c16 & 3)) * 2;
#pragma unroll
            for (int n = 0; n < NDV; ++n) { const bf16x8 vf = cat4(tr_read(v0 + n * 32), tr_read(v0 + 16 * SV + n * 32)); acc_o[n] = MFMA16(vf, pf, acc_o[n]); } }
        } }
    }
    l = radd32(radd16(l));
    if (MODE == 1) l += ex2(sink_l2 - m);
    const float inv = 1.0f / l;
#pragma unroll
    for (int n = 0; n < NDV; ++n) { v2u o; o.x = pk2(acc_o[n][0] * inv, acc_o[n][1] * inv); o.y = pk2(acc_o[n][2] * inv, acc_o[n][3] * inv); *(v2u*)(O + (size_t)qrow * ldo + 16 * n + 4 * g) = o; }
#undef FL_KT
#undef FL_LOAD
#undef FL_STORE
}

template <int NH>
__device__ __forceinline__ void swa_gqa_unit(LAS unsigned char* lds, const bf16* Q, const bf16* K, int ldk, const bf16* V, int ldv, bf16* O, int qb, gfp sinks, int tid) {
    constexpr int SK = 64 * 2 + 16, SV = 64 * 2 + 32  , KB = 64 * SK, VB = 64 * SV, BUF = KB + VB;
    const int lane = tid & 63, w = __builtin_amdgcn_readfirstlane(tid >> 6), g = lane >> 4, c16 = lane & 15;
    const int q0 = qb * 128, qrow = q0 + 16 * w + c16;
    const int first2 = (2 * qb - 2) > 2 ? (2 * qb - 2) : 2;
    const int nt = 1 + ((2 * qb + 2 - first2) > 0 ? (2 * qb + 2 - first2) : 0);
#define FL_KT(it) ((it) == 0 ? 1 : first2 + (it) - 1)
    bf16x8 qf[NH][2];
#pragma unroll
    for (int hh = 0; hh < NH; ++hh)
#pragma unroll
        for (int ks = 0; ks < 2; ++ks) qf[hh][ks] = *(const bf16x8*)(Q + (size_t)qrow * 1024 + hh * 64 + 32 * ks + 8 * g);
    f32x4 acc_o[NH][4]; float m[NH], l[NH];
#pragma unroll
    for (int hh = 0; hh < NH; ++hh) { m[hh] = -1e30f; l[hh] = 0.f;
#pragma unroll
        for (int n = 0; n < 4; ++n) acc_o[hh][n] = (f32x4){0.f, 0.f, 0.f, 0.f}; }
    const int r_ = tid >> 3, cc_ = tid & 7;
    v4u kr, vr;
    { const int key0_ = 64 * FL_KT(0); kr = *(const v4u*)(K + (size_t)(key0_ + r_) * ldk + cc_ * 8); vr = *(const v4u*)(V + (size_t)(key0_ + r_) * ldv + cc_ * 8); }
    for (int it = 0; it < nt; ++it) {
        const int buf = it & 1, key0 = 64 * FL_KT(it);
        *(LAS v4u*)(lds + buf * BUF + r_ * SK + cc_ * 16) = kr; *(LAS v4u*)(lds + buf * BUF + KB + r_ * SV + cc_ * 16) = vr;
        __syncthreads();
        if (it + 1 < nt) { const int key0_ = 64 * FL_KT(it + 1); kr = *(const v4u*)(K + (size_t)(key0_ + r_) * ldk + cc_ * 8); vr = *(const v4u*)(V + (size_t)(key0_ + r_) * ldv + cc_ * 8); }
        const LAS unsigned char* kb = lds + buf * BUF; const LAS unsigned char* vb = kb + KB;
#pragma unroll
        for (int hh = 0; hh < NH; ++hh) {
            f32x4 s[4];
#pragma unroll
            for (int t = 0; t < 4; ++t) { s[t] = (f32x4){0.f, 0.f, 0.f, 0.f};
#pragma unroll
                for (int ks = 0; ks < 2; ++ks) { const bf16x8 kf = *(const LAS bf16x8*)(kb + (16 * t + c16) * SK + (32 * ks + 8 * g) * 2); s[t] = MFMA16(kf, qf[hh][ks], s[t]); } }
#pragma unroll
            for (int t = 0; t < 4; ++t)
#pragma unroll
                for (int r = 0; r < 4; ++r) { const int k = key0 + 16 * t + 4 * g + r;
                    const bool vis = (k >= PADR) & (k <= qrow) & (((qrow - k) < 128) | (k < 128)); s[t][r] = vis ? s[t][r] : -1e30f; }
            float mx; { const float ma = max8f(s[0], s[1]), mb = max8f(s[2], s[3]); mx = max3f(ma, mb, mb); }
            if (!__all(mx <= m[hh] + 8.0f)) {
                mx = rmax32(rmax16(mx));
                const float mn = fmaxf(m[hh], mx), al = ex2(m[hh] - mn); m[hh] = mn; l[hh] *= al;
#pragma unroll
                for (int n = 0; n < 4; ++n) acc_o[hh][n] = acc_o[hh][n] * al; }
            const float mc = m[hh]; float ps = 0.f;
#pragma unroll
            for (int t = 0; t < 4; ++t)
#pragma unroll
                for (int r = 0; r < 4; ++r) { s[t][r] = ex2(s[t][r] - mc); ps += s[t][r]; }
            l[hh] += ps;
#pragma unroll
            for (int tp = 0; tp < 2; ++tp) { const bf16x8 pf = pack_p(s[2 * tp], s[2 * tp + 1]); const LAS unsigned char* v0 = vb + (32 * tp + 4 * g + (c16 >> 2)) * SV + (4 * (c16 & 3)) * 2;
#pragma unroll
                for (int n = 0; n < 4; ++n) { const bf16x8 vf = cat4(tr_read(v0 + n * 32), tr_read(v0 + 16 * SV + n * 32)); acc_o[hh][n] = MFMA16(vf, pf, acc_o[hh][n]); } }
        }
    }
#pragma unroll
    for (int hh = 0; hh < NH; ++hh) {
        float lt = l[hh]; lt = radd32(radd16(lt));
        lt += ex2(sinks[hh] * LOG2E - m[hh]);
        const float inv = 1.0f / lt;
#pragma unroll
        for (int n = 0; n < 4; ++n) { v2u o; o.x = pk2(acc_o[hh][n][0] * inv, acc_o[hh][n][1] * inv); o.y = pk2(acc_o[hh][n][2] * inv, acc_o[hh][n][3] * inv); *(v2u*)(O + (size_t)qrow * 1024 + hh * 64 + 16 * n + 4 * g) = o; }
    }
#undef FL_KT
}

template <int DQK, int DV, int MODE, int PRB = 0  >
__device__ __forceinline__ void flash_unit2(LAS unsigned char* lds, const bf16* Q, int ldq, const bf16* K, int ldk, const bf16* V, int ldv, bf16* O, int ldo, int qb, float sink_l2, int tid) {
    constexpr int SK = DQK * 2 + 16, SV = DV * 2 + 32  , KB = 64 * SK, VB = 64 * SV, BUF = KB + VB;
    constexpr int KCH = DQK / 8, VCH = DV / 8, NKC = 64 * KCH / 512, NVC = 64 * VCH / 512, NKS = DQK / 32, NDV = DV / 16, NEX = 2 * NDV * 4 + 4;
    static_assert(64 * KCH % 512 == 0 && 64 * VCH % 512 == 0 && 2 * BUF <= RING_BYTES && 4 * NEX * 256 <= RING_BYTES, "flash tile geometry");
    const int lane = tid & 63, w = __builtin_amdgcn_readfirstlane(tid >> 6), qw = w & 3, kh = w >> 2, g = lane >> 4, c16 = lane & 15;
    const int q0 = qb * 128, qbase = q0 + 32 * qw;
    const int first2 = MODE == 0 ? 2 : ((2 * qb - 2) > 2 ? (2 * qb - 2) : 2);
    const int nt = MODE == 0 ? 2 * qb + 1 : 1 + ((2 * qb + 2 - first2) > 0 ? (2 * qb + 2 - first2) : 0);
#define FL_KT(it) ((it) == 0 ? 1 : first2 + (it) - 1)
    bf16x8 qf[2][NKS];
#pragma unroll
    for (int sb = 0; sb < 2; ++sb)
#pragma unroll
        for (int ks = 0; ks < NKS; ++ks) qf[sb][ks] = *(const bf16x8*)(Q + (size_t)(qbase + 16 * sb + c16) * ldq + 32 * ks + 8 * g);
    v4u kr[2][NKC], vr[2][NVC];
    unsigned kofs[NKC], vofs[NVC];
#pragma unroll
    for (int j = 0; j < NKC; ++j) { const int c = tid + 512 * j; kofs[j] = (unsigned)(((c / KCH) * ldk + (c % KCH) * 8) * 2); }
#pragma unroll
    for (int j = 0; j < NVC; ++j) { const int c = tid + 512 * j; vofs[j] = (unsigned)(((c / VCH) * ldv + (c % VCH) * 8) * 2); }
#define FL_LOAD(kt, P) do { const char* kb_ = (const char*)K + (size_t)(64 * (kt)) * ldk * 2; const char* vb_ = (const char*)V + (size_t)(64 * (kt)) * ldv * 2; \
        _Pragma("unroll") for (int j = 0; j < NKC; ++j) kr[P][j] = *(const v4u*)(kb_ + kofs[j]); \
        _Pragma("unroll") for (int j = 0; j < NVC; ++j) vr[P][j] = *(const v4u*)(vb_ + vofs[j]); } while (0)
#define FL_STORE(buf, P) do { \
        _Pragma("unroll") for (int j = 0; j < NKC; ++j) { const int c = tid + 512 * j, r = c / KCH, cc = c % KCH; *(LAS v4u*)(lds + (buf) * BUF + r * SK + cc * 16) = kr[P][j]; } \
        _Pragma("unroll") for (int j = 0; j < NVC; ++j) { const int c = tid + 512 * j, r = c / VCH, cc = c % VCH; *(LAS v4u*)(lds + (buf) * BUF + KB + r * SV + cc * 16) = vr[P][j]; } } while (0)
    f32x4 acc_o[2][NDV];
#pragma unroll
    for (int sb = 0; sb < 2; ++sb)
#pragma unroll
        for (int n = 0; n < NDV; ++n) acc_o[sb][n] = (f32x4){0.f, 0.f, 0.f, 0.f};
    float m[2] = {-1e30f, -1e30f}, l[2] = {0.f, 0.f};
    FL_LOAD(FL_KT(0), 0);
    if (nt > 1) FL_LOAD(FL_KT(1), 1);
    FL_STORE(0, 0);
    if (nt > 2) FL_LOAD(FL_KT(2), 0);
    for (int it2 = 0; it2 < nt; it2 += 2) {
#pragma unroll
        for (int P = 0; P < 2; ++P) {
        const int it = it2 + P;
        if (it < nt) {
        const int buf = P, key0 = 64 * FL_KT(it) + 32 * kh;
        __syncthreads();
        if (it + 1 < nt) { FL_STORE(1 - P, 1 - P); if (it + 3 < nt) FL_LOAD(FL_KT(it + 3), 1 - P); }
        const LAS unsigned char* kb = lds + buf * BUF + (32 * kh) * SK; const LAS unsigned char* vb = lds + buf * BUF + KB + (32 * kh) * SV;
        f32x4 s[2][2];
#pragma unroll
        for (int sb = 0; sb < 2; ++sb)
#pragma unroll
            for (int t = 0; t < 2; ++t) s[sb][t] = (f32x4){0.f, 0.f, 0.f, 0.f};
        if (PRB < 2) {
        {
#define FL_RK(e) (*(const LAS bf16x8*)(kb + (16 * ((e) / NKS) + c16) * SK + (32 * ((e) % NKS) + 8 * g) * 2))
            bf16x8 kq[3]; kq[0] = FL_RK(0); kq[1] = FL_RK(1);
#pragma unroll
            for (int e = 0; e < 2 * NKS; ++e) { if (e + 2 < 2 * NKS) kq[(e + 2) % 3] = FL_RK(e + 2);
                s[0][e / NKS] = MFMA16(kq[e % 3], qf[0][e % NKS], s[0][e / NKS]); s[1][e / NKS] = MFMA16(kq[e % 3], qf[1][e % NKS], s[1][e / NKS]);
                }
#undef FL_RK
        }
        }
        const bool need_mask = PRB == 0 && (MODE == 1 || key0 < 128 || key0 + 31 > qbase);
        bf16x8 pf[2];
#pragma unroll
        for (int sb = 0; sb < 2; ++sb) {
            const int qrow = qbase + 16 * sb + c16;
            if (need_mask) {
#pragma unroll
                for (int t = 0; t < 2; ++t)
#pragma unroll
                    for (int r = 0; r < 4; ++r) { const int k = key0 + 16 * t + 4 * g + r;
                        bool vis = k >= PADR && k <= qrow; if (MODE == 1) vis = vis && (qrow - k < 128 || k < 128);
                        if (!vis) s[sb][t][r] = -1e30f; }
            }
            if (PRB == 0) {
            float mx = max8f(s[sb][0], s[sb][1]);
            if (!__all(mx <= m[sb] + 8.0f)) {
                mx = rmax32(rmax16(mx));
                const float mn = fmaxf(m[sb], mx), al = ex2(m[sb] - mn); m[sb] = mn; l[sb] *= al;
#pragma unroll
                for (int n = 0; n < NDV; ++n) acc_o[sb][n] = acc_o[sb][n] * al; }
            const float mc = m[sb]; float ps = 0.f;
#pragma unroll
            for (int t = 0; t < 2; ++t)
#pragma unroll
                for (int r = 0; r < 4; ++r) { s[sb][t][r] = ex2(s[sb][t][r] - mc); ps += s[sb][t][r]; }
            l[sb] += ps;
            }
            pf[sb] = pack_p(s[sb][0], s[sb][1]);
        }
        const LAS unsigned char* v0 = vb + (4 * g + (c16 >> 2)) * SV + (4 * (c16 & 3)) * 2;
        if (PRB < 2) {
#define FL_RV(n) cat4(tr_read(v0 + (n) * 32), tr_read(v0 + 16 * SV + (n) * 32))
            bf16x8 vq[3]; vq[0] = FL_RV(0); vq[1] = FL_RV(1);
#pragma unroll
            for (int n = 0; n < NDV; ++n) { if (n + 2 < NDV) vq[(n + 2) % 3] = FL_RV(n + 2);
                acc_o[0][n] = MFMA16(vq[n % 3], pf[0], acc_o[0][n]); acc_o[1][n] = MFMA16(vq[n % 3], pf[1], acc_o[1][n]);
                }
#undef FL_RV
        }
        } }
    }
#pragma unroll
    for (int sb = 0; sb < 2; ++sb) { l[sb] = radd32(radd16(l[sb])); }
    __syncthreads();
    LAS float* ex = (LAS float*)lds + (size_t)qw * NEX * 64 + lane;
    if (kh == 1) {
#pragma unroll
        for (int sb = 0; sb < 2; ++sb) {
#pragma unroll
            for (int n = 0; n < NDV; ++n)
#pragma unroll
                for (int r = 0; r < 4; ++r) ex[((sb * NDV + n) * 4 + r) * 64] = acc_o[sb][n][r];
            ex[(2 * NDV * 4 + sb) * 64] = m[sb]; ex[(2 * NDV * 4 + 2 + sb) * 64] = l[sb]; }
    }
    __syncthreads();
    if (kh == 0) {
#pragma unroll
        for (int sb = 0; sb < 2; ++sb) {
            const float mb = ex[(2 * NDV * 4 + sb) * 64], lb = ex[(2 * NDV * 4 + 2 + sb) * 64];
            const float mt = fmaxf(m[sb], mb), fa = ex2(m[sb] - mt), fb = ex2(mb - mt);
            float lt = l[sb] * fa + lb * fb;
            if (MODE == 1) lt += ex2(sink_l2 - mt);
            const float inv = 1.0f / lt; const int qrow = qbase + 16 * sb + c16;
#pragma unroll
            for (int n = 0; n < NDV; ++n) { float o[4];
#pragma unroll
                for (int r = 0; r < 4; ++r) o[r] = (acc_o[sb][n][r] * fa + ex[((sb * NDV + n) * 4 + r) * 64] * fb) * inv;
                v2u ov; ov.x = pk2(o[0], o[1]); ov.y = pk2(o[2], o[3]); *(v2u*)(O + (size_t)qrow * ldo + 16 * n + 4 * g) = ov; }
        }
    }
#undef FL_KT
#undef FL_LOAD
#undef FL_STORE
}

__device__ __forceinline__ void ret_kv_unit(LAS unsigned char* lds, const bf16* Zk  , const bf16* Vp, float* KVC, float lg2  ,
                                            int t0  , const float* C64, const float* S64, int tid) {
    constexpr int SKk = 128 * 2 + 32, SVv = 256 * 2 + 32  , KOFF = 0, VOFF = 128 * SKk;
    const int lane = tid & 63, w = __builtin_amdgcn_readfirstlane(tid >> 6), g = lane >> 4, c16 = lane & 15;
#pragma unroll
    for (int j = 0; j < 2; ++j) { const int it = tid + 512 * j, r = it >> 3, cc = it & 7, t = t0 + r; float x1[8], x2[8];
        unpack8(*(const v4u*)(Zk + (size_t)r * NINP + cc * 8), x1); unpack8(*(const v4u*)(Zk + (size_t)r * NINP + 64 + cc * 8), x2);
        const f32x4 ca = *(const f32x4*)(C64 + t * 64 + cc * 8), cb = *(const f32x4*)(C64 + t * 64 + cc * 8 + 4), sa = *(const f32x4*)(S64 + t * 64 + cc * 8), sb = *(const f32x4*)(S64 + t * 64 + cc * 8 + 4);
        const float z = (t >= PADR ? RET_KS : 0.f) * ex2((float)(127 - r) * lg2); float o1[8], o2[8];
#pragma unroll
        for (int i = 0; i < 8; ++i) { const float c = i < 4 ? ca[i & 3] : cb[i & 3], sn = i < 4 ? sa[i & 3] : sb[i & 3]; o1[i] = (x1[i] * c - x2[i] * sn) * z; o2[i] = (x2[i] * c + x1[i] * sn) * z; }
        *(LAS v4u*)(lds + KOFF + r * SKk + cc * 16) = pack8(o1); *(LAS v4u*)(lds + KOFF + r * SKk + 128 + cc * 16) = pack8(o2); }
#pragma unroll
    for (int j = 0; j < 8; ++j) { const int c = tid + 512 * j, r = c >> 5, cc = c & 31; *(LAS v4u*)(lds + VOFF + r * SVv + cc * 16) = *(const v4u*)(Vp + (size_t)r * NINP + cc * 8); }
    __syncthreads();
    f32x4 acc[2][8];
#pragma unroll
    for (int i = 0; i < 2; ++i)
#pragma unroll
        for (int j = 0; j < 8; ++j) acc[i][j] = (f32x4){0.f, 0.f, 0.f, 0.f};
    const int roff = 8 * g + (c16 >> 2), coff = 4 * (c16 & 3);
#pragma unroll
    for (int ks = 0; ks < 4; ++ks) {
        bf16x8 af[2];
#pragma unroll
        for (int i = 0; i < 2; ++i) { const LAS unsigned char* p = lds + VOFF + (32 * ks + roff) * SVv + (16 * (2 * w + i) + coff) * 2; af[i] = cat4(tr_read(p), tr_read(p + 4 * SVv)); }
#pragma unroll
        for (int j = 0; j < 8; ++j) { const LAS unsigned char* p = lds + KOFF + (32 * ks + roff) * SKk + (16 * j + coff) * 2; const bf16x8 bfr = cat4(tr_read(p), tr_read(p + 4 * SKk));
#pragma unroll
            for (int i = 0; i < 2; ++i) acc[i][j] = MFMA16(af[i], bfr, acc[i][j]); }
    }
#pragma unroll
    for (int i = 0; i < 2; ++i)
#pragma unroll
        for (int j = 0; j < 8; ++j) *(f32x4*)(KVC + (size_t)(16 * j + c16) * 256 + 16 * (2 * w + i) + 4 * g) = acc[i][j];
}
__device__ __forceinline__ void ret_out_unit(LAS unsigned char* lds, const bf16* Qp, const bf16* Kp, const bf16* Vp, const bf16* Sp  , const bf16* Gp  ,
                                             gfp gn  , bf16* Op, float lg2, int tid) {
    constexpr int SKk = 128 * 2 + 16, SVv = 256 * 2 + 32, KOFF = 0, VOFF = 128 * SKk;
    const int lane = tid & 63, w = __builtin_amdgcn_readfirstlane(tid >> 6), g = lane >> 4, c16 = lane & 15, ql = 16 * w + c16;
#pragma unroll
    for (int j = 0; j < 4; ++j) { const int c = tid + 512 * j, r = c >> 4, cc = c & 15; *(LAS v4u*)(lds + KOFF + r * SKk + cc * 16) = *(const v4u*)(Kp + (size_t)r * 512 + cc * 8); }
#pragma unroll
    for (int j = 0; j < 8; ++j) { const int c = tid + 512 * j, r = c >> 5, cc = c & 31; *(LAS v4u*)(lds + VOFF + r * SVv + cc * 16) = *(const v4u*)(Vp + (size_t)r * NINP + cc * 8); }
    bf16x8 qf[4];
#pragma unroll
    for (int ks = 0; ks < 4; ++ks) qf[ks] = *(const bf16x8*)(Qp + (size_t)ql * 512 + 32 * ks + 8 * g);
    v2u gwv[16];
#pragma unroll
    for (int n = 0; n < 16; ++n) gwv[n] = *(const v2u*)(Gp + (size_t)ql * NINP + 16 * n + 4 * g);
    __syncthreads();
    f32x4 acc_o[16];
#pragma unroll
    for (int n = 0; n < 16; ++n) acc_o[n] = (f32x4){0.f, 0.f, 0.f, 0.f};
#pragma unroll
    for (int tp = 0; tp < 4; ++tp) {
        if (2 * tp <= w) {
            f32x4 s[2];
#pragma unroll
            for (int u = 0; u < 2; ++u) { const int t = 2 * tp + u; s[u] = (f32x4){0.f, 0.f, 0.f, 0.f};
#pragma unroll
                for (int ks = 0; ks < 4; ++ks) { const bf16x8 kf = *(const LAS bf16x8*)(lds + KOFF + (16 * t + c16) * SKk + (32 * ks + 8 * g) * 2); s[u] = MFMA16(kf, qf[ks], s[u]); }
#pragma unroll
                for (int r = 0; r < 4; ++r) { const int d = ql - (16 * t + 4 * g + r); s[u][r] = d >= 0 ? s[u][r] * ex2((float)d * lg2) : 0.f; } }
            const bf16x8 pf = pack_p(s[0], s[1]);
            const LAS unsigned char* v0 = lds + VOFF + (32 * tp + 4 * g + (c16 >> 2)) * SVv + (4 * (c16 & 3)) * 2;
#pragma unroll
            for (int n = 0; n < 16; ++n) { const bf16x8 vf = cat4(tr_read(v0 + n * 32), tr_read(v0 + 16 * SVv + n * 32)); acc_o[n] = MFMA16(vf, pf, acc_o[n]); }
        }
    }
    __syncthreads();
#pragma unroll
    for (int j = 0; j < 8; ++j) { const int c = tid + 512 * j, r = c >> 5, cc = c & 31; *(LAS v4u*)(lds + VOFF + r * SVv + cc * 16) = *(const v4u*)(Sp + (size_t)r * 256 + cc * 8); }
    { const float xi = ex2((float)(ql + 1) * lg2);
#pragma unroll
      for (int ks = 0; ks < 4; ++ks) { float f[8]; unpack8(__builtin_bit_cast(v4u, qf[ks]), f);
#pragma unroll
          for (int i = 0; i < 8; ++i) f[i] *= xi;
          qf[ks] = __builtin_bit_cast(bf16x8, pack8(f)); } }
    __syncthreads();
    const int roff = 8 * g + (c16 >> 2), coff = 4 * (c16 & 3);
#pragma unroll
    for (int ks = 0; ks < 4; ++ks) {
        const LAS unsigned char* p0 = lds + VOFF + (32 * ks + roff) * SVv + coff * 2;
#pragma unroll
        for (int n = 0; n < 16; ++n) { const bf16x8 sf = cat4(tr_read(p0 + n * 32), tr_read(p0 + 4 * SVv + n * 32)); acc_o[n] = MFMA16(sf, qf[ks], acc_o[n]); }
    }
    float sum = 0.f;
#pragma unroll
    for (int n = 0; n < 16; ++n) sum += (acc_o[n][0] + acc_o[n][1]) + (acc_o[n][2] + acc_o[n][3]);
    sum = radd32(radd16(sum));
    const float mu = sum * (1.0f / 256.0f); float qq = 0.f;
#pragma unroll
    for (int n = 0; n < 16; ++n) { acc_o[n] = acc_o[n] - mu; qq += (acc_o[n][0] * acc_o[n][0] + acc_o[n][1] * acc_o[n][1]) + (acc_o[n][2] * acc_o[n][2] + acc_o[n][3] * acc_o[n][3]); }
    qq = radd32(radd16(qq));
    const float rs = rsqrtf(qq * (1.0f / 256.0f) + EPS);
    f32x4 ggv[16];
#pragma unroll
    for (int n = 0; n < 16; ++n) ggv[n] = *(const GAS f32x4*)(gn + 16 * n + 4 * g);
#pragma unroll
    for (int n = 0; n < 16; ++n) { const int dv = 16 * n + 4 * g; const f32x4 gg = ggv[n]; const v2u gw = gwv[n];
        const float t0 = blo(gw.x), t1 = bhi(gw.x), t2 = blo(gw.y), t3 = bhi(gw.y);
        v2u o; o.x = pk2(acc_o[n][0] * rs * gg[0] * (t0 * __builtin_amdgcn_rcpf(1.0f + __expf(-t0))), acc_o[n][1] * rs * gg[1] * (t1 * __builtin_amdgcn_rcpf(1.0f + __expf(-t1))));
        o.y = pk2(acc_o[n][2] * rs * gg[2] * (t2 * __builtin_amdgcn_rcpf(1.0f + __expf(-t2))), acc_o[n][3] * rs * gg[3] * (t3 * __builtin_amdgcn_rcpf(1.0f + __expf(-t3))));
        *(v2u*)(Op + (size_t)ql * 1024 + dv) = o; }
}
#ifndef FLASH_MLA
#define FLASH_MLA flash_unit2
#endif
#ifndef FLASH_SWA
#define FLASH_SWA flash_unit
#endif
#ifndef REP_REST
#define REP_REST 1
#endif
#ifndef REP_GU
#define REP_GU 1
#endif
#ifndef REP_CONV
#define REP_CONV 1
#endif
#ifndef REP_ROW
#define REP_ROW 1
#endif
#ifndef REP_MIX
#define REP_MIX 1
#endif
constexpr int CW_Q = 8192;
#define RET_LG2(h) __builtin_amdgcn_logf(1.0f - ex2(-5.0f - (float)(h)))
#define G_EXTRA { PHASE_VARS for (int u = blockIdx.x; u < 256; u += G) { __syncthreads(); const int n = u & 31, bh = u >> 5, b = bh >> 2, h = bh & 3; const size_t r0 = (size_t)b * LP + 128 * n; \
    ret_kv_unit(lds, Z + r0 * NINP + ORK + h * 128, Z + r0 * NINP + ORV + h * 256, KVC + (size_t)(bh * 33 + n) * 32768, RET_LG2(h), 128 * n, C64, S64, tid); } \
    G_SWA }
#define H_EXTRA { PHASE_VARS const int e = blockIdx.x * (NWAVES * 64) + tid; if (e < 131072) { const int bh = e >> 14, off = (e & 16383) * 2; typedef float f32x2_t __attribute__((ext_vector_type(2))); \
    float cd = 1.0f - ex2(-5.0f - (float)(bh & 3)); _Pragma("unroll") for (int i = 0; i < 7; ++i) cd *= cd; \
    f32x2_t kvv[32]; _Pragma("unroll") for (int n = 0; n < 32; ++n) kvv[n] = *(const f32x2_t*)(KVC + (size_t)(bh * 33 + n) * 32768 + off); \
    f32x2_t st = (f32x2_t){0.f, 0.f}; \
    _Pragma("unroll") for (int n = 0; n < 33; ++n) { *(unsigned*)(PREV + (size_t)(bh * 33 + n) * 32768 + off) = pk2(st[0], st[1]); if (n < 32) st = st * cd + kvv[n]; } } }
#define MIXERS_MLA for (;;) { const int u = pop_unit(CTL + CW_Q + ((rep * DEPTH + l) * 4 + 0) * 64, MISC + 16, tid); if (u >= 528) break; const int qb = 32 - (u >> 4), b = (u >> 3) & 1, h = u & 7; const size_t r0 = (size_t)b * LP; int tid_u = tid; asm volatile("" : "+v"(tid_u)); \
    FLASH_MLA<192, 128, 0>(lds, QM + r0 * 1536 + h * 192, 1536, KM + r0 * 1536 + h * 192, 1536, KVRAW + r0 * 2048 + h * 256 + 128, 2048, OB + r0 * 1024 + h * 128, 1024, qb, 0.f, tid_u); }
#define MIXERS_MLA_PRB for (;;) { const int u = pop_unit(CTL + CW_Q + ((rep * DEPTH + l) * 4 + 0) * 64, MISC + 16, tid); if (u >= 528) break; const int qb = 32 - (u >> 4), b = (u >> 3) & 1, h = u & 7; const size_t r0 = (size_t)b * LP; int tid_u = tid; asm volatile("" : "+v"(tid_u)); \
    flash_unit2<192, 128, 0, MLA_PRB>(lds, QM + r0 * 1536 + h * 192, 1536, KM + r0 * 1536 + h * 192, 1536, KVRAW + r0 * 2048 + h * 256 + 128, 2048, (bf16*)MF + r0 * 1024 + h * 128, 1024, qb, 0.f, tid_u); }
#define MIXERS_SWA for (;;) { const int u = pop_unit(CTL + CW_Q + ((rep * DEPTH + l) * 4 + 1) * 64, MISC + 16, tid); if (u >= 528) break; const int qb = 32 - (u >> 4), b = (u >> 3) & 1, hp = u & 7, kvh = hp >> 2; const size_t r0 = (size_t)b * LP; \
    swa_gqa_unit<2>(lds, QS + r0 * 1024 + hp * 128, KS + r0 * 128 + kvh * 64, 128, Z + r0 * NINP + OSV + kvh * 64, NINP, OA + r0 * 1024 + hp * 128, qb, IN(I_SINK) + l * 16 + hp * 2, tid); }
#define MIXERS_RET for (;;) { const int u = pop_unit(CTL + CW_Q + ((rep * DEPTH + l) * 4 + 2) * 64, MISC + 16, tid); if (u >= 264) break; const int n = u % 33, bh = u / 33, b = bh >> 2, h = bh & 3; const size_t r0 = (size_t)b * LP + 128 * n; int tid_u = tid; asm volatile("" : "+v"(tid_u)); \
    ret_out_unit(lds, RQ + r0 * 512 + h * 128, RK + r0 * 512 + h * 128, Z + r0 * NINP + ORV + h * 256, PREV + (size_t)(bh * 33 + n) * 32768, Z + r0 * NINP + ORG + h * 256, IN(I_RGN) + l * 1024 + h * 256, OC + r0 * 1024 + h * 256, RET_LG2(h), tid_u); }
#ifndef MIX_SEL
#define MIX_SEL 7
#endif
#if (MIX_SEL & 1)
#define MX_A MIXERS_MLA
#else
#define MX_A mla_scalar(QM, KM, KVRAW, OB, gw, NGW, lane);
#endif
#if (MIX_SEL & 8)
#define MX_B
#define G_SWA { const int rep = 0; MIXERS_SWA }
#elif (MIX_SEL & 2)
#define G_SWA
#define MX_B MIXERS_SWA
#else
#define G_SWA
#define MX_B swa_scalar(QS, KS, Z, IN(I_SINK) + l * 16, OA, gw, NGW, lane);
#endif
#if (MIX_SEL & 4)
#define MX_C MIXERS_RET
#else
#define MX_C ret_scalar(RQ, RK, Z, IN(I_RGN) + l * 1024, OC, gw, NGW, lane);
#endif
#if REP_MIX == 4
#define MIXERS_BODY { PHASE_VARS { const int rep = 0; MX_C MX_A MX_B } } { PHASE_VARS { const int rep = 1; MIXERS_MLA_PRB } }
#elif REP_MIX == 10
#define MIXERS_BODY { PHASE_VARS { const int rep = 0; MX_C MX_A MX_B } } { PHASE_VARS { const int rep = 1; MX_A } } { PHASE_VARS { const int rep = 2; MX_A } } { PHASE_VARS { const int rep = 3; MX_A } }
#elif REP_MIX == 2
#define MIXERS_BODY { PHASE_VARS { const int rep = 0; MX_C MX_A MX_B } } { PHASE_VARS { const int rep = 1; MX_C MX_A MX_B } }
#else
#define MIXERS_BODY { PHASE_VARS { const int rep = 0; MX_C MX_A MX_B } }
#endif
struct Args { const float* in[28]; float* out; unsigned char* ws; };
enum { I_X = 0, I_META, I_F1N, I_F1G, I_F1U, I_F1D, I_MIXN, I_WIN, I_SQN, I_SKN, I_SINK, I_QAN, I_WUQ, I_KVAN, I_WUKV, I_QNN, I_QRN, I_KNN, I_KRN, I_RGN, I_WBS, I_WBM, I_WBR, I_WO, I_F2N, I_F2G, I_F2U, I_F2D };

__global__ void __launch_bounds__(NWAVES * 64, 2) fwd(Args a) {
    extern __shared__ __attribute__((aligned(16))) unsigned char lds_raw[];
    LAS unsigned char* lds = (LAS unsigned char*)lds_raw;
    volatile LAS unsigned* MISC = (volatile LAS unsigned*)(lds + MISC_OFF);
    {
        const int tid0 = threadIdx.x;
        for (int u = tid0; u < (LDS_BYTES - LDSCTL_OFF) / 4; u += NWAVES * 64) ((LAS unsigned*)(lds + LDSCTL_OFF))[u] = 0u;
        __syncthreads();
        if (tid0 < 28) ((LAS unsigned long long*)(lds + PTAB_OFF))[tid0] = (unsigned long long)a.in[tid0];
        __syncthreads();
    }
    const int G = gridDim.x, NGW = G * NWAVES, wave0 = __builtin_amdgcn_readfirstlane((int)(threadIdx.x >> 6));
    XcdBarrier bar = xcd_barrier_post((unsigned*)(a.ws + WS_CTL) + CW_BAR, MISC + 8);
#define GRID_BAR() do { XcdBarrier b2_ = bar; unsigned long long bi_ = (unsigned long long)b2_.bar; unsigned zz_ = 0u; asm volatile("" : "+s"(bi_), "+s"(b2_.x), "+v"(zz_)); b2_.zz = zz_; b2_.bar = (unsigned*)(GAS unsigned*)bi_; xcd_barrier(b2_); } while (0)
#define PHASE_VARS unsigned z0_ = 0u; asm volatile("" : "+v"(z0_)); const int tid = wave0 * 64 + (int)__builtin_amdgcn_mbcnt_hi(~0u, __builtin_amdgcn_mbcnt_lo(~0u, z0_)); const int lane = tid & 63, wave = __builtin_amdgcn_readfirstlane(tid >> 6), gw = blockIdx.x * NWAVES + wave; \
    unsigned long long wsi_ = (unsigned long long)a.ws; asm volatile("" : "+s"(wsi_)); unsigned char* ws = (unsigned char*)(GAS unsigned char*)wsi_; (void)lane; (void)gw; \
    LAS float* const scr = (LAS float*)(lds + wave * 16384); (void)scr;
#define IN(i) in_ptr(lds, (i))
#define H ((float*)(ws + WS_H))
#define HN ((bf16*)(ws + WS_HN))
#define ACT ((bf16*)(ws + WS_ACT))
#define Z ((bf16*)(ws + WS_Z))
#define QS ((bf16*)(ws + WS_QS))
#define KS ((bf16*)(ws + WS_KS))
#define CQN ((bf16*)(ws + WS_CQN))
#define CKVN ((bf16*)(ws + WS_CKVN))
#define QRAW ((bf16*)(ws + WS_QRAW))
#define KVRAW ((bf16*)(ws + WS_KVRAW))
#define QM ((bf16*)(ws + WS_QM))
#define KM ((bf16*)(ws + WS_KM))
#define RQ ((bf16*)(ws + WS_RQ))
#define RK ((bf16*)(ws + WS_RK))
#define OA ((bf16*)(ws + WS_OA))
#define OB ((bf16*)(ws + WS_OB))
#define OC ((bf16*)(ws + WS_OC))
#define MF ((float*)(ws + WS_MF))
#define MB ((bf16*)(ws + WS_MB))
#define C64 ((float*)(ws + WS_C64))
#define S64 ((float*)(ws + WS_S64))
#define C32 ((float*)(ws + WS_C32))
#define S32 ((float*)(ws + WS_S32))
#define KVC ((float*)(ws + WS_KVC))
#define PREV ((bf16*)(ws + WS_PREV))
#define CTL ((unsigned*)(ws + WS_CTL))
#define PART ((float*)(ws + WS_PART))
#define SSQ ((float*)(ws + WS_SSQ))
#define RS ((float*)(ws + WS_RS))
#define SSQC ((float*)(ws + WS_SSQC))

    {
        PHASE_VARS
        for (int row = gw; row < M; row += NGW) { const int b = row >= LP ? 1 : 0, t = row - b * LP; float* hr = H + (size_t)row * D;
            gfp src = t >= 128 ? IN(I_X) + (size_t)(b * SEQ + t - 128) * D : IN(I_META) + (size_t)(t >= PADR ? t - PADR : 0) * D;
#pragma unroll
            for (int j = 0; j < 8; ++j) { f32x4 v = *(const GAS f32x4*)(src + 4 * lane + 256 * j); if (t < PADR) v = (f32x4){0.f, 0.f, 0.f, 0.f}; *(f32x4*)(hr + 4 * lane + 256 * j) = v; }
            fix_row(hr, HN + (size_t)row * D, RS + row, lane, nullptr, 0); }
        const int gt = blockIdx.x * (NWAVES * 64) + tid, NGT = G * NWAVES * 64;
        for (int e = gt; e < LP * 64; e += NGT) { const int t = e >> 6, i = e & 63; const double ang = (double)(t - PADR) * exp2(-(double)i * (13.287712379549449 / 64.0));
            const double k = rint(ang * 0.15915494309189535); const float r = (float)(ang - k * 6.283185307179586); C64[e] = cosf(r); S64[e] = sinf(r); }
        for (int e = gt; e < LP * 32; e += NGT) { const int t = e >> 5, i = e & 31; const double ang = (double)(t - PADR) * exp2(-(double)i * (13.287712379549449 / 32.0));
            const double k = rint(ang * 0.15915494309189535); const float r = (float)(ang - k * 6.283185307179586); C32[e] = cosf(r); S32[e] = sinf(r); }
        v4u* zp = (v4u*)(ws + W_IN + (size_t)NIN * D * 2);
        for (int e = gt; e < (NINP - NIN) * D * 2 / 16; e += NGT) zp[e] = (v4u){0u, 0u, 0u, 0u};
    }
    GRID_BAR();

    for (int l = 0; l < DEPTH; ++l) {
        {
            PHASE_VARS
            constexpr int I_FFN = (D / 64) * (FF / 32), I_DN = (FF / 64) * (D / 32), I_IN = (D / 64) * (NIN / 32), I_UQ = (512 / 64) * (1536 / 32), I_UKV = (512 / 64) * (2048 / 32), I_BR = (1024 / 64) * (D / 32), I_O = (D / 64) * (D / 32);
            constexpr int NITEMS = 4 * I_FFN + 2 * I_DN + I_IN + I_UQ + I_UKV + 3 * I_BR + I_O;
            for (int rep = 0; rep < REP_CONV; ++rep)
            for (int it = gw; it < NITEMS; it += NGW) {
                int r = it;
                if (r < I_FFN) { cvt_gu(IN(I_F1G) + (size_t)l * D * FF, (bf16*)(ws + W_GU1), 0, r, scr, lane, IN(I_F1N) + l * D); continue; } r -= I_FFN;
                if (r < I_FFN) { cvt_gu(IN(I_F1U) + (size_t)l * D * FF, (bf16*)(ws + W_GU1), 1, r, scr, lane, IN(I_F1N) + l * D); continue; } r -= I_FFN;
                if (r < I_FFN) { cvt_gu(IN(I_F2G) + (size_t)l * D * FF, (bf16*)(ws + W_GU2), 0, r, scr, lane, IN(I_F2N) + l * D); continue; } r -= I_FFN;
                if (r < I_FFN) { cvt_gu(IN(I_F2U) + (size_t)l * D * FF, (bf16*)(ws + W_GU2), 1, r, scr, lane, IN(I_F2N) + l * D); continue; } r -= I_FFN;
                if (r < I_DN) { cvt_plain(IN(I_F1D) + (size_t)l * D * FF, FF, D, (bf16*)(ws + W_D1), r, scr, lane, (gfp)nullptr); continue; } r -= I_DN;
                if (r < I_DN) { cvt_plain(IN(I_F2D) + (size_t)l * D * FF, FF, D, (bf16*)(ws + W_D2), r, scr, lane, (gfp)nullptr); continue; } r -= I_DN;
                if (r < I_IN) { cvt_plain(IN(I_WIN) + (size_t)l * D * NIN, D, NIN, (bf16*)(ws + W_IN), r, scr, lane, IN(I_MIXN) + l * D); continue; } r -= I_IN;
                if (r < I_UQ) { cvt_plain(IN(I_WUQ) + (size_t)l * 512 * 1536, 512, 1536, (bf16*)(ws + W_UQ), r, scr, lane, IN(I_QAN) + l * 512); continue; } r -= I_UQ;
                if (r < I_UKV) { cvt_plain(IN(I_WUKV) + (size_t)l * 512 * 2048, 512, 2048, (bf16*)(ws + W_UKV), r, scr, lane, IN(I_KVAN) + l * 512); continue; } r -= I_UKV;
                if (r < I_BR) { cvt_plain(IN(I_WBS) + (size_t)l * 1024 * D, 1024, D, (bf16*)(ws + W_BS), r, scr, lane, (gfp)nullptr); continue; } r -= I_BR;
                if (r < I_BR) { cvt_plain(IN(I_WBM) + (size_t)l * 1024 * D, 1024, D, (bf16*)(ws + W_BM), r, scr, lane, (gfp)nullptr); continue; } r -= I_BR;
                if (r < I_BR) { cvt_plain(IN(I_WBR) + (size_t)l * 1024 * D, 1024, D, (bf16*)(ws + W_BR), r, scr, lane, (gfp)nullptr); continue; } r -= I_BR;
                cvt_plain(IN(I_WO) + (size_t)l * D * D, D, D, (bf16*)(ws + W_O), r, scr, lane, (gfp)nullptr);
            }
            if (l > 0) { fix_panel32<22>(H, HN, RS + (size_t)(l * 3) * M + 8192, PART, (volatile LAS float*)(MISC + 32), tid, lane, wave);
                row_scales(SSQ + (size_t)(l * 3) * M * 32, RS + (size_t)(l * 3) * M, blockIdx.x * (NWAVES * 64) + tid, G * NWAVES * 64); }
        }
        GRID_BAR();
        { PHASE_VARS pg8::Gemm g{HN, (const bf16*)(ws + W_GU1), M, NGU, D, D}; pg8::StaticOrder S; S.init(g, G, (int)blockIdx.x); pg8::EpiSwiglu E{ACT, FF, RS + (size_t)(l * 3) * M};
          pg8::gemm_phase<pg8::EpiSwiglu, pg8::StaticOrder, true, true>(lds, g, S, E, tid); }
#if REP_GU == 2
        GRID_BAR();
        { PHASE_VARS pg8::Gemm g{HN, (const bf16*)(ws + W_GU1), M, NGU, D, D}; pg8::StaticOrder S; S.init(g, G, (int)blockIdx.x); pg8::EpiSwiglu E{ACT, FF, RS + (size_t)(l * 3) * M};
          pg8::gemm_phase<pg8::EpiSwiglu, pg8::StaticOrder, true, true>(lds, g, S, E, tid); }
#elif REP_GU == 3
        GRID_BAR();
        { PHASE_VARS pg8::Gemm g{HN, (const bf16*)(ws + W_GU1), M, NGU, D, D}; pg8::StaticOrder S; S.init(g, G, (int)blockIdx.x); pg8::EpiNull E{};
          pg8::gemm_phase<pg8::EpiNull, pg8::StaticOrder, true, true>(lds, g, S, E, tid); }
#elif REP_GU == 4
        GRID_BAR();
        { PHASE_VARS pg8::Gemm g{HN, (const bf16*)(ws + W_GU1), M, NGU, D, D}; pg8::SameTileOrder S; S.init(g, G, (int)blockIdx.x); pg8::EpiNull E{};
          pg8::gemm_phase<pg8::EpiNull, pg8::SameTileOrder, true, true>(lds, g, S, E, tid); }
#endif
        GRID_BAR();
#if REP_REST == 2
        { PHASE_VARS pg8::Gemm g{ACT, (const bf16*)(ws + W_D1), M, D, FF, FF}; pg8::TailOrder S; S.init(g, 22, (int)blockIdx.x); pg8::EpiResidT<0> E{H, PART, 0ull, HN, (float*)nullptr};
          pg8::gemm_phase<decltype(E), pg8::TailOrder, true, true>(lds, g, S, E, tid); }
        GRID_BAR();
#endif
        { PHASE_VARS pg8::Gemm g{ACT, (const bf16*)(ws + W_D1), M, D, FF, FF}; pg8::TailOrder S; S.init(g, 22, (int)blockIdx.x); pg8::EpiResidT<1> E{H, PART, 0ull, HN, SSQ + (size_t)(l * 3 + 1) * M * 32};
          pg8::gemm_phase<decltype(E), pg8::TailOrder, true, true>(lds, g, S, E, tid); }
        GRID_BAR();
        { PHASE_VARS fix_panel32<22>(H, HN, RS + (size_t)(l * 3 + 1) * M + 8192, PART, (volatile LAS float*)(MISC + 32), tid, lane, wave);
          row_scales(SSQ + (size_t)(l * 3 + 1) * M * 32, RS + (size_t)(l * 3 + 1) * M, blockIdx.x * (NWAVES * 64) + tid, G * NWAVES * 64); }
        GRID_BAR();
#if REP_REST == 2
        { PHASE_VARS pg8::Gemm g{HN, (const bf16*)(ws + W_IN), M, NINP, D, D}; pg8::StaticOrder S; S.init(g, G, (int)blockIdx.x); pg8::EpiZ E{Z, NINP, RS + (size_t)(l * 3 + 1) * M, SSQC};
          pg8::gemm_phase<pg8::EpiZ, pg8::StaticOrder, true, true>(lds, g, S, E, tid); }
        GRID_BAR();
#endif
        { PHASE_VARS pg8::Gemm g{HN, (const bf16*)(ws + W_IN), M, NINP, D, D}; pg8::StaticOrder S; S.init(g, G, (int)blockIdx.x); pg8::EpiZ E{Z, NINP, RS + (size_t)(l * 3 + 1) * M, SSQC};
          pg8::gemm_phase<pg8::EpiZ, pg8::StaticOrder, true, true>(lds, g, S, E, tid); }
        GRID_BAR();
        { PHASE_VARS pg8::Gemm g{Z + OCQ, (const bf16*)(ws + W_UQ), M, 3584, 512, NINP}; pg8::DualOrder S; S.init(g, G, (int)blockIdx.x); S.A2 = (const char*)(Z + OCKV); S.B1 = (const char*)(ws + W_UQ); S.B2 = (const char*)(ws + W_UKV);
          pg8::EpiQKV E{QRAW, KVRAW, SSQC};
          pg8::gemm_phase<pg8::EpiQKV, pg8::DualOrder, true, true>(lds, g, S, E, tid); }
        G_EXTRA
        GRID_BAR();
        { PHASE_VARS
        for (int rep = 0; rep < REP_ROW; ++rep)
        for (int row = gw; row < M; row += NGW) {
            const int b = row >= LP ? 1 : 0, t = row - b * LP; const bf16* zr = Z + (size_t)row * NINP;
            const int h = lane >> 3, part = lane & 7, ll = lane & 15, i32 = lane & 31, h4 = lane >> 4, i0r = 4 * (lane & 15), i0q = 4 * part;
            const v4u Lq0 = *(const v4u*)(zr + OQ + 16 * lane), Lq1 = *(const v4u*)(zr + OQ + 16 * lane + 8);
            const v4u Lk = *(const v4u*)(zr + OSK + 8 * ll);
            const bf16 Lr1 = zr[OKR + i32], Lr2 = zr[OKR + 32 + i32];
            const v2u Lrq1 = *(const v2u*)(zr + ORQ + h4 * 128 + i0r), Lrq2 = *(const v2u*)(zr + ORQ + h4 * 128 + i0r + 64);
            const v2u Lrk1 = *(const v2u*)(zr + ORK + h4 * 128 + i0r), Lrk2 = *(const v2u*)(zr + ORK + h4 * 128 + i0r + 64);
            const f32x4 Lc64 = *(const f32x4*)(C64 + t * 64 + i0r), Ls64 = *(const f32x4*)(S64 + t * 64 + i0r);
            const float Lc32 = C32[t * 32 + i32], Ls32 = S32[t * 32 + i32];
            const bf16* pq = QRAW + (size_t)row * 1536 + h * 192;
            const v4u Lqn0 = *(const v4u*)(pq + 16 * part), Lqn1 = *(const v4u*)(pq + 16 * part + 8);
            const v2u Lqr1 = *(const v2u*)(pq + 128 + i0q), Lqr2 = *(const v2u*)(pq + 160 + i0q);
            const f32x4 Lc32v = *(const f32x4*)(C32 + t * 32 + i0q), Ls32v = *(const f32x4*)(S32 + t * 32 + i0q);
            const bf16* pk = KVRAW + (size_t)row * 2048 + h * 256 + 16 * part;
            const v4u Lkn0 = *(const v4u*)pk, Lkn1 = *(const v4u*)(pk + 8);
            f32x4 Gq[4], Gk[2], Gqn[4], Gkn[4];
            { gfp g = IN(I_SQN) + l * 64 + ((16 * lane) & 63);
#pragma unroll
              for (int i = 0; i < 4; ++i) Gq[i] = *(const GAS f32x4*)(g + 4 * i); }
            { gfp g = IN(I_SKN) + l * 64 + ((8 * ll) & 63); Gk[0] = *(const GAS f32x4*)g; Gk[1] = *(const GAS f32x4*)(g + 4); }
            const float Gr1 = IN(I_KRN)[l * 64 + i32], Gr2 = IN(I_KRN)[l * 64 + 32 + i32];
            { gfp g = IN(I_QNN) + l * 128 + 16 * part;
#pragma unroll
              for (int i = 0; i < 4; ++i) Gqn[i] = *(const GAS f32x4*)(g + 4 * i); }
            const f32x4 Gqr1 = *(const GAS f32x4*)(IN(I_QRN) + l * 64 + i0q), Gqr2 = *(const GAS f32x4*)(IN(I_QRN) + l * 64 + 32 + i0q);
            { gfp g = IN(I_KNN) + l * 128 + 16 * part;
#pragma unroll
              for (int i = 0; i < 4; ++i) Gkn[i] = *(const GAS f32x4*)(g + 4 * i); }
            {
                float f[16]; unpack8(Lq0, f); unpack8(Lq1, f + 8);
                float ss = 0.f;
#pragma unroll
                for (int i = 0; i < 16; ++i) ss += f[i] * f[i];
                const float r = rsqrtf(grp_sum<4>(ss, lane) * (1.0f / 64.0f) + EPS) * SWA_QS;
#pragma unroll
                for (int i = 0; i < 16; ++i) f[i] *= r * Gq[i >> 2][i & 3];
                *(v4u*)(QS + (size_t)row * 1024 + 16 * lane) = pack8(f); *(v4u*)(QS + (size_t)row * 1024 + 16 * lane + 8) = pack8(f + 8);
            }
            {
                float f[8]; unpack8(Lk, f);
                float ss = 0.f;
#pragma unroll
                for (int i = 0; i < 8; ++i) ss += f[i] * f[i];
                const float r = rsqrtf(grp_sum<8>(ss, lane) * (1.0f / 64.0f) + EPS);
#pragma unroll
                for (int i = 0; i < 8; ++i) f[i] *= r * Gk[i >> 2][i & 3];
                if (lane < 16) *(v4u*)(KS + (size_t)row * 128 + 8 * ll) = pack8(f);
            }
            {
                const float x1 = bf2f(Lr1), x2 = bf2f(Lr2);
                const float ss = wave_sum(lane < 32 ? x1 * x1 + x2 * x2 : 0.f, lane); const float r = rsqrtf(ss * (1.0f / 64.0f) + EPS);
                const float y1 = x1 * r * Gr1, y2 = x2 * r * Gr2;
                const bf16 o1 = (bf16)f2bf(y1 * Lc32 - y2 * Ls32), o2 = (bf16)f2bf(y2 * Lc32 + y1 * Ls32);
                if (lane < 32) {
#pragma unroll
                    for (int hh = 0; hh < 8; ++hh) { KM[(size_t)row * 1536 + hh * 192 + 128 + i32] = o1; KM[(size_t)row * 1536 + hh * 192 + 160 + i32] = o2; } }
            }
#pragma unroll
            for (int which = 0; which < 2; ++which) {
                const v2u w1 = which ? Lrk1 : Lrq1, w2 = which ? Lrk2 : Lrq2;
                const float x1[4] = {blo(w1.x), bhi(w1.x), blo(w1.y), bhi(w1.y)}, x2[4] = {blo(w2.x), bhi(w2.x), blo(w2.y), bhi(w2.y)};
                const float sc = which ? (t >= PADR ? RET_KS : 0.f) : 1.f;
                float o1[4], o2[4];
#pragma unroll
                for (int j = 0; j < 4; ++j) { o1[j] = (x1[j] * Lc64[j] - x2[j] * Ls64[j]) * sc; o2[j] = (x2[j] * Lc64[j] + x1[j] * Ls64[j]) * sc; }
                bf16* q = (which ? RK : RQ) + (size_t)row * 512 + h4 * 128 + i0r;
                v2u u1, u2; u1.x = pk2(o1[0], o1[1]); u1.y = pk2(o1[2], o1[3]); u2.x = pk2(o2[0], o2[1]); u2.y = pk2(o2[2], o2[3]);
                *(v2u*)q = u1; *(v2u*)(q + 64) = u2;
            }
            {
                float f[16]; unpack8(Lqn0, f); unpack8(Lqn1, f + 8);
                float ss = 0.f;
#pragma unroll
                for (int i = 0; i < 16; ++i) ss += f[i] * f[i];
                const float r = rsqrtf(grp_sum<8>(ss, lane) * (1.0f / 128.0f) + EPS) * MLA_QS;
#pragma unroll
                for (int i = 0; i < 16; ++i) f[i] *= r * Gqn[i >> 2][i & 3];
                bf16* q = QM + (size_t)row * 1536 + h * 192 + 16 * part; *(v4u*)q = pack8(f); *(v4u*)(q + 8) = pack8(f + 8);
            }
            {
                float x1[4] = {blo(Lqr1.x), bhi(Lqr1.x), blo(Lqr1.y), bhi(Lqr1.y)}, x2[4] = {blo(Lqr2.x), bhi(Lqr2.x), blo(Lqr2.y), bhi(Lqr2.y)};
                float ss = 0.f;
#pragma unroll
                for (int j = 0; j < 4; ++j) ss += x1[j] * x1[j] + x2[j] * x2[j];
                const float r = rsqrtf(grp_sum<8>(ss, lane) * (1.0f / 64.0f) + EPS);
                float o1[4], o2[4];
#pragma unroll
                for (int j = 0; j < 4; ++j) { const float y1 = x1[j] * r * Gqr1[j], y2 = x2[j] * r * Gqr2[j]; o1[j] = (y1 * Lc32v[j] - y2 * Ls32v[j]) * MLA_QS; o2[j] = (y2 * Lc32v[j] + y1 * Ls32v[j]) * MLA_QS; }
                bf16* q = QM + (size_t)row * 1536 + h * 192 + 128 + i0q;
                v2u u1, u2; u1.x = pk2(o1[0], o1[1]); u1.y = pk2(o1[2], o1[3]); u2.x = pk2(o2[0], o2[1]); u2.y = pk2(o2[2], o2[3]);
                *(v2u*)q = u1; *(v2u*)(q + 32) = u2;
            }
            {
                float f[16]; unpack8(Lkn0, f); unpack8(Lkn1, f + 8);
                float ss = 0.f;
#pragma unroll
                for (int i = 0; i < 16; ++i) ss += f[i] * f[i];
                const float r = rsqrtf(grp_sum<8>(ss, lane) * (1.0f / 128.0f) + EPS);
#pragma unroll
                for (int i = 0; i < 16; ++i) f[i] *= r * Gkn[i >> 2][i & 3];
                bf16* q = KM + (size_t)row * 1536 + h * 192 + 16 * part; *(v4u*)q = pack8(f); *(v4u*)(q + 8) = pack8(f + 8);
            }
        } }
        H_EXTRA
        GRID_BAR();
        MIXERS_BODY
        GRID_BAR();
#if REP_REST == 2
        { PHASE_VARS pg8::Gemm g{OA, (const bf16*)(ws + W_BS), M, D, 1024, 1024};
          static_assert(WS_OB - WS_OA == WS_OC - WS_OB && W_BM - W_BS == W_BR - W_BM, "equally spaced branch buffers");
          pg8::BranchOrder S{(int)blockIdx.x, (const char*)OA, (const char*)(ws + W_BS), WS_OB - WS_OA, W_BM - W_BS};
          pg8::EpiGateR E{Z + OG, NINP, MB, PART};
          pg8::gemm_phase<pg8::EpiGateR, pg8::BranchOrder, true, true>(lds, g, S, E, tid); }
        GRID_BAR();
#endif
        { PHASE_VARS pg8::Gemm g{OA, (const bf16*)(ws + W_BS), M, D, 1024, 1024};
          static_assert(WS_OB - WS_OA == WS_OC - WS_OB && W_BM - W_BS == W_BR - W_BM, "equally spaced branch buffers");
          pg8::BranchOrder S{(int)blockIdx.x, (const char*)OA, (const char*)(ws + W_BS), WS_OB - WS_OA, W_BM - W_BS};
          pg8::EpiGateR E{Z + OG, NINP, MB, PART};
          pg8::gemm_phase<pg8::EpiGateR, pg8::BranchOrder, true, true>(lds, g, S, E, tid); }
        GRID_BAR();
        { PHASE_VARS for (int lrow = blockIdx.x; lrow < 256; lrow += G) { const int col = 256 * wave + 4 * lane; f32x4 pp[12];
#pragma unroll
            for (int sidx = 0; sidx < 12; ++sidx) pp[sidx] = *(const f32x4*)(PART + ((size_t)sidx * 256 + lrow) * 2048 + col);
            f32x4 v = pp[0];
#pragma unroll
            for (int sidx = 1; sidx < 12; ++sidx) v = v + pp[sidx];
            v2u w; w.x = pk2(v.x, v.y); w.y = pk2(v.z, v.w); *(v2u*)(MB + (size_t)(8192 + lrow) * 2048 + col) = w; } }
        GRID_BAR();
#if REP_REST == 2
        { PHASE_VARS pg8::Gemm g{MB, (const bf16*)(ws + W_O), M, D, D, D}; pg8::TailOrder S; S.init(g, 8, (int)blockIdx.x); pg8::EpiResidT<0> E{H, PART, 0ull, HN, (float*)nullptr};
          pg8::gemm_phase<decltype(E), pg8::TailOrder, true, true>(lds, g, S, E, tid); }
        GRID_BAR();
#endif
        { PHASE_VARS pg8::Gemm g{MB, (const bf16*)(ws + W_O), M, D, D, D}; pg8::TailOrder S; S.init(g, 8, (int)blockIdx.x); pg8::EpiResidT<2> E{H, PART, 0ull, HN, SSQ + (size_t)(l * 3 + 2) * M * 32};
          pg8::gemm_phase<decltype(E), pg8::TailOrder, true, true>(lds, g, S, E, tid); }
        GRID_BAR();
        { PHASE_VARS fix_panel32<8>(H, HN, RS + (size_t)(l * 3 + 2) * M + 8192, PART, (volatile LAS float*)(MISC + 32), tid, lane, wave);
          row_scales(SSQ + (size_t)(l * 3 + 2) * M * 32, RS + (size_t)(l * 3 + 2) * M, blockIdx.x * (NWAVES * 64) + tid, G * NWAVES * 64); }
        GRID_BAR();
        { PHASE_VARS pg8::Gemm g{HN, (const bf16*)(ws + W_GU2), M, NGU, D, D}; pg8::StaticOrder S; S.init(g, G, (int)blockIdx.x); pg8::EpiSwiglu E{ACT, FF, RS + (size_t)(l * 3 + 2) * M};
          pg8::gemm_phase<pg8::EpiSwiglu, pg8::StaticOrder, true, true>(lds, g, S, E, tid); }
#if REP_GU == 2
        GRID_BAR();
        { PHASE_VARS pg8::Gemm g{HN, (const bf16*)(ws + W_GU2), M, NGU, D, D}; pg8::StaticOrder S; S.init(g, G, (int)blockIdx.x); pg8::EpiSwiglu E{ACT, FF, RS + (size_t)(l * 3 + 2) * M};
          pg8::gemm_phase<pg8::EpiSwiglu, pg8::StaticOrder, true, true>(lds, g, S, E, tid); }
#elif REP_GU == 3
        GRID_BAR();
        { PHASE_VARS pg8::Gemm g{HN, (const bf16*)(ws + W_GU2), M, NGU, D, D}; pg8::StaticOrder S; S.init(g, G, (int)blockIdx.x); pg8::EpiNull E{};
          pg8::gemm_phase<pg8::EpiNull, pg8::StaticOrder, true, true>(lds, g, S, E, tid); }
#elif REP_GU == 4
        GRID_BAR();
        { PHASE_VARS pg8::Gemm g{HN, (const bf16*)(ws + W_GU2), M, NGU, D, D}; pg8::SameTileOrder S; S.init(g, G, (int)blockIdx.x); pg8::EpiNull E{};
          pg8::gemm_phase<pg8::EpiNull, pg8::SameTileOrder, true, true>(lds, g, S, E, tid); }
#endif
        GRID_BAR();
#if REP_REST == 2
        { PHASE_VARS pg8::Gemm g{ACT, (const bf16*)(ws + W_D2), M, D, FF, FF}; pg8::TailOrder S; S.init(g, 22, (int)blockIdx.x); pg8::EpiResidT<0> E{H, PART, 0ull, HN, (float*)nullptr};
          pg8::gemm_phase<decltype(E), pg8::TailOrder, true, true>(lds, g, S, E, tid); }
        GRID_BAR();
#endif
        { PHASE_VARS pg8::Gemm g{ACT, (const bf16*)(ws + W_D2), M, D, FF, FF}; pg8::TailOrder S; S.init(g, 22, (int)blockIdx.x); pg8::EpiResidT<1> E{H, PART, l == DEPTH - 1 ? (unsigned long long)a.out : 0ull, HN, l == DEPTH - 1 ? (float*)nullptr : SSQ + (size_t)((l + 1) * 3) * M * 32};
          pg8::gemm_phase<decltype(E), pg8::TailOrder, true, true>(lds, g, S, E, tid); }
        GRID_BAR();
    }
    { PHASE_VARS for (int lrow = gw; lrow < 256; lrow += NGW) { const int row = 8192 + lrow;
#pragma unroll
        for (int jj = 0; jj < 8; ++jj) { f32x4 v = *(const f32x4*)(H + (size_t)row * D + 4 * lane + 256 * jj);
            for (int sidx = 0; sidx < 22; ++sidx) v = v + *(const f32x4*)(PART + ((size_t)sidx * 256 + lrow) * 2048 + 4 * lane + 256 * jj);
            *(f32x4*)(a.out + (size_t)(row - 256) * D + 4 * lane + 256 * jj) = v; } } }
}
extern "C" void kernel_launch(void* const* d_in, const int* in_sizes, int n_in, void* d_out, int out_size, void* d_ws, size_t ws_size, hipStream_t stream) {
    static int grid = 0;
    if (grid == 0) {
        if (n_in != 28 || in_sizes[0] != NB * SEQ * D || out_size != NB * SEQ * D || ws_size < WS_END) {
            fprintf(stderr, "kernel_launch: unexpected shapes: n_in %d, in0 %d, out %d, ws %zu (need %zu); nothing launched\n", n_in, n_in > 0 ? in_sizes[0] : -1, out_size, ws_size, (size_t)WS_END); grid = -1; return; }
        int dev = 0, cus = 0, per_cu = 0;
        if (hipGetDevice(&dev) != hipSuccess || hipDeviceGetAttribute(&cus, hipDeviceAttributeMultiprocessorCount, dev) != hipSuccess) { fprintf(stderr, "kernel_launch: device query failed\n"); grid = -1; return; }
        if (hipFuncSetAttribute((const void*)fwd, hipFuncAttributeMaxDynamicSharedMemorySize, LDS_BYTES) != hipSuccess) { fprintf(stderr, "kernel_launch: hipFuncSetAttribute failed\n"); grid = -1; return; }
        if (hipOccupancyMaxActiveBlocksPerMultiprocessor(&per_cu, (const void*)fwd, NWAVES * 64, LDS_BYTES) != hipSuccess || per_cu < 1) {
            fprintf(stderr, "kernel_launch: occupancy query reports %d workgroups per CU; nothing launched\n", per_cu); (void)hipGetLastError(); grid = -1; return; }
        (void)hipGetLastError();
        if (cus != 256) { fprintf(stderr, "kernel_launch: built for a 256-CU device (the unit orders of the N = 2048 GEMMs assume 256 workgroups); found %d; nothing launched\n", cus); grid = -1; return; }
        grid = cus;
    }
    if (grid < 0) return;
    if (hipMemsetAsync((char*)d_ws + WS_CTL, 0, CTL_ZERO_BYTES, stream) != hipSuccess) { fprintf(stderr, "kernel_launch: memset failed\n"); return; }
    Args a{};
    for (int i = 0; i < 28; ++i) a.in[i] = (const float*)d_in[i];
    a.out = (float*)d_out; a.ws = (unsigned char*)d_ws;
    hipLaunchKernelGGL(fwd, dim3(grid), dim3(NWAVES * 64), LDS_BYTES, stream, a);
    const hipError_t le = hipPeekAtLastError();
    if (le != hipSuccess) fprintf(stderr, "kernel_launch: launch failed: %s\n", hipGetErrorName(le));
}
```
